# Optimizing an MI355X kernel written in HIP

```python
import math
import jax
import jax.numpy as jnp
from jax import lax
import numpy as np

D_MODEL = 1024
BATCH = 4
SEQ = 4096
DEPTH = 2

GRID_W = 64
CTX_LEN = 256
HEAD_DIM = 64
N_BRANCH = 4
BRANCH_WIDTH = 512
NA_HEADS = 8
NA_WIN_ROWS = 8
NA_WIN_COLS = 16
SWA_HEADS = 8
SWA_KV_HEADS = 2
SWA_WINDOW = 128
SWA_BLOCK = 128
S5_WIDTH = 512
S5_GROUP = 16
S5_GROUPS = S5_WIDTH // S5_GROUP
S5_STATE = 64
S5_DT_MIN = 0.001
S5_DT_MAX = 0.1
MLA_HEADS = 8
MLA_Q_LORA = 256
MLA_KV_LORA = 128
MLA_NOPE = 64
MLA_ROPE = 32
MLA_V = 64
MLA_BLOCK = 128
D_FF = 2816
MACARON_WEIGHT = 0.5
ROPE_BASE = 10000.0
EPS = 1e-6
N_MOD = 9
IN_SPLITS = (NA_HEADS * HEAD_DIM, NA_HEADS * HEAD_DIM, NA_HEADS * HEAD_DIM,
             SWA_HEADS * HEAD_DIM, SWA_KV_HEADS * HEAD_DIM, SWA_KV_HEADS * HEAD_DIM,
             S5_WIDTH, MLA_Q_LORA, MLA_KV_LORA, MLA_ROPE, N_BRANCH * D_MODEL)
IN_COLS = sum(IN_SPLITS)

kernel_name = 'hybrid_na_swa_s5_mla_diffusion_block'


def rms_norm(x, w):
    xf = x.astype(jnp.float32)
    y = xf * lax.rsqrt(jnp.mean(xf * xf, axis=-1, keepdims=True) + EPS)
    return (y * w.astype(jnp.float32)).astype(x.dtype)


def modulate(x, shift, scale):
    return x * (1.0 + scale) + shift


def swiglu(x, w_gate, w_up, w_down):
    return (jax.nn.silu(x @ w_gate) * (x @ w_up)) @ w_down


def macaron_half_ffn(h, shift, scale, gate, norm_w, w_gate, w_up, w_down):
    n = modulate(rms_norm(h, norm_w), shift, scale)
    return h + MACARON_WEIGHT * gate * swiglu(n, w_gate, w_up, w_down)


def split_heads(t, n_heads):
    return t.reshape(t.shape[:-1] + (n_heads, t.shape[-1] // n_heads))


def split_columns(t):
    parts, off = [], 0
    for width in IN_SPLITS:
        parts.append(t[..., off:off + width])
        off += width
    return parts


def rope_2d(x, rows, cols):
    dim = x.shape[-1]
    half_axis = dim // 2
    n_freq = half_axis // 2
    inv_freq = ROPE_BASE ** (-jnp.arange(n_freq, dtype=jnp.float32) / n_freq)

    def rotate(xa, pos):
        ang = pos.astype(jnp.float32)[:, None] * inv_freq[None, :]
        cos = jnp.cos(ang)[None, :, None, :]
        sin = jnp.sin(ang)[None, :, None, :]
        x1, x2 = xa[..., :n_freq], xa[..., n_freq:]
        return jnp.concatenate([x1 * cos - x2 * sin, x2 * cos + x1 * sin], axis=-1)

    xf = x.astype(jnp.float32)
    out = jnp.concatenate([rotate(xf[..., :half_axis], rows), rotate(xf[..., half_axis:], cols)], axis=-1)
    return out.astype(x.dtype)


def softmax_with_sink(s, sink):
    m = jnp.maximum(jnp.max(s, axis=-1, keepdims=True), sink)
    e = jnp.exp(s - m)
    return e / (jnp.sum(e, axis=-1, keepdims=True) + jnp.exp(sink - m))


def ctx_attention(q, k, v, sink=None):
    B, C, Hq, dq = q.shape
    Hk = k.shape[2]
    G = Hq // Hk
    qg = q.reshape(B, C, Hk, G, dq)
    s = jnp.einsum('bqkgd,bckd->bkgqc', qg, k).astype(jnp.float32) * dq ** -0.5
    if sink is None:
        p = jax.nn.softmax(s, axis=-1)
    else:
        p = softmax_with_sink(s, sink.astype(jnp.float32).reshape(Hk, G)[None, :, :, None, None])
    o = jnp.einsum('bkgqc,bckd->bqkgd', p.astype(v.dtype), v)
    return o.reshape(B, C, Hq * v.shape[-1])


def neighbourhood_attention(q, k, v, kc, vc, rpb):
    B, T, H, d = q.shape
    rows_n = T // GRID_W
    kr = min(NA_WIN_ROWS, rows_n)
    n_loc = kr * NA_WIN_COLS
    scale = d ** -0.5
    qg = q.reshape(B, rows_n, GRID_W, H, d)
    kg = k.reshape(B, rows_n, GRID_W, H, d)
    vg = v.reshape(B, rows_n, GRID_W, H, d)
    col = jnp.arange(GRID_W)
    c0 = jnp.clip(col - NA_WIN_COLS // 2, 0, GRID_W - NA_WIN_COLS)
    col_idx = c0[:, None] + jnp.arange(NA_WIN_COLS)[None, :]
    col_bias_idx = col_idx - col[:, None] + (NA_WIN_COLS - 1)
    rpb32 = rpb.astype(jnp.float32)

    def one_row(args):
        r, q_r = args
        r0 = jnp.clip(r - kr // 2, 0, rows_n - kr)
        k_win = lax.dynamic_slice_in_dim(kg, r0, kr, axis=1)[:, :, col_idx]
        v_win = lax.dynamic_slice_in_dim(vg, r0, kr, axis=1)[:, :, col_idx]
        row_bias_idx = r0 + jnp.arange(kr) - r + (NA_WIN_ROWS - 1)
        bias = rpb32[:, row_bias_idx[None, :, None], col_bias_idx[:, None, :]]
        s_loc = jnp.einsum('bqhd,brqjhd->bhqrj', q_r, k_win).astype(jnp.float32) * scale + bias[None]
        s_ctx = jnp.einsum('bqhd,bchd->bhqc', q_r, kc).astype(jnp.float32) * scale
        p = jax.nn.softmax(jnp.concatenate([s_loc.reshape(B, H, GRID_W, n_loc), s_ctx], axis=-1), axis=-1).astype(v.dtype)
        p_loc = p[..., :n_loc].reshape(B, H, GRID_W, kr, NA_WIN_COLS)
        return (jnp.einsum('bhqrj,brqjhd->bqhd', p_loc, v_win)
                + jnp.einsum('bhqc,bchd->bqhd', p[..., n_loc:], vc))

    out = lax.map(one_row, (jnp.arange(rows_n), jnp.moveaxis(qg, 1, 0)))
    return jnp.moveaxis(out, 0, 1).reshape(B, T, H * d)


def sliding_window_attention(q, k, v, kc, vc, sink):
    B, T, Hq, d = q.shape
    Hk = k.shape[2]
    G = Hq // Hk
    blk = SWA_BLOCK
    nb = T // blk
    scale = d ** -0.5
    qb = q.reshape(B, nb, blk, Hk, G, d)
    pad = ((0, 0), (blk, blk), (0, 0), (0, 0))
    kp = jnp.pad(k, pad).reshape(B, nb + 2, blk, Hk, d)
    vp = jnp.pad(v, pad).reshape(B, nb + 2, blk, Hk, d)
    kband = jnp.concatenate([kp[:, :-2], kp[:, 1:-1], kp[:, 2:]], axis=2)
    vband = jnp.concatenate([vp[:, :-2], vp[:, 1:-1], vp[:, 2:]], axis=2)
    qpos = jnp.arange(nb)[:, None] * blk + jnp.arange(blk)[None, :]
    kpos = (jnp.arange(nb)[:, None] - 1) * blk + jnp.arange(3 * blk)[None, :]
    valid = ((jnp.abs(qpos[:, :, None] - kpos[:, None, :]) <= SWA_WINDOW)
             & (kpos[:, None, :] >= 0) & (kpos[:, None, :] < T))
    s_loc = jnp.einsum('bnqkgd,bnckd->bnkgqc', qb, kband).astype(jnp.float32) * scale
    s_loc = jnp.where(valid[None, :, None, None], s_loc, -jnp.inf)
    s_ctx = jnp.einsum('bnqkgd,bckd->bnkgqc', qb, kc).astype(jnp.float32) * scale
    sink_b = sink.astype(jnp.float32).reshape(Hk, G)[None, None, :, :, None, None]
    p = softmax_with_sink(jnp.concatenate([s_loc, s_ctx], axis=-1), sink_b).astype(v.dtype)
    n_loc = 3 * blk
    o = (jnp.einsum('bnkgqc,bnckd->bnqkgd', p[..., :n_loc], vband)
         + jnp.einsum('bnkgqc,bckd->bnqkgd', p[..., n_loc:], vc))
    return o.reshape(B, T, Hq * d)


def mla_query(cq, p, rows, cols):
    q = split_heads(rms_norm(cq, p['mla_q_norm']) @ p['mla_w_uq'], MLA_HEADS)
    q_nope, q_rope = q[..., :MLA_NOPE], q[..., MLA_NOPE:]
    if rows is not None:
        q_rope = rope_2d(q_rope, rows, cols)
    return jnp.concatenate([q_nope, q_rope], axis=-1)


def mla_keys_values(ckv, k_rope, p, rows, cols):
    kv = split_heads(rms_norm(ckv, p['mla_kv_norm']) @ p['mla_w_ukv'], MLA_HEADS)
    k_nope, v = kv[..., :MLA_NOPE], kv[..., MLA_NOPE:]
    kr = k_rope[..., None, :]
    if rows is not None:
        kr = rope_2d(kr, rows, cols)
    k = jnp.concatenate([k_nope, jnp.broadcast_to(kr, k_nope.shape[:-1] + (MLA_ROPE,))], axis=-1)
    return k, v


def mla_dense_attention(q, k, v, kc, vc):
    B, T, H, dq = q.shape
    dv = v.shape[-1]
    scale = dq ** -0.5
    k_all = jnp.concatenate([k, kc], axis=1)
    v_all = jnp.concatenate([v, vc], axis=1)
    nb = T // MLA_BLOCK
    qb = jnp.moveaxis(q.reshape(B, nb, MLA_BLOCK, H, dq), 1, 0)

    def one_block(q_blk):
        s = jnp.einsum('bqhd,bkhd->bhqk', q_blk, k_all).astype(jnp.float32) * scale
        pr = jax.nn.softmax(s, axis=-1).astype(v.dtype)
        return jnp.einsum('bhqk,bkhd->bqhd', pr, v_all)

    o = lax.map(one_block, qb)
    return jnp.moveaxis(o, 0, 1).reshape(B, T, H * dv)


def linear_recurrence(e1, e2):
    a1, b1 = e1
    a2, b2 = e2
    return a1 * a2, a2 * b1 + b2


def s5_discretise(lam_re, lam_im, log_dt, b_re, b_im, c_re, c_im):
    lam = lax.complex(lam_re.astype(jnp.float32), lam_im.astype(jnp.float32))
    dt = jnp.exp(log_dt.astype(jnp.float32))[:, None]
    lam_bar = jnp.exp(lam * dt)
    b = lax.complex(b_re.astype(jnp.float32), b_im.astype(jnp.float32))
    b_bar = ((lam_bar - 1.0) / lam)[..., None] * b
    c = lax.complex(c_re.astype(jnp.float32), c_im.astype(jnp.float32))
    return lam_bar, b_bar, c


def s5_states(u, lam_bar, b_bar, h0, reverse):
    bu = jnp.einsum('gpc,btgc->btgp', b_bar, u.astype(jnp.complex64))
    if h0 is not None:
        first = -1 if reverse else 0
        bu = bu.at[:, first].add(lam_bar * h0)
    a = jnp.broadcast_to(lam_bar, bu.shape)
    _, h = lax.associative_scan(linear_recurrence, (a, bu), reverse=reverse, axis=1)
    return h


def s5_readout(c, h):
    B, T = h.shape[0], h.shape[1]
    return jnp.einsum('gcp,btgp->btgc', c, h).real.reshape(B, T, S5_WIDTH)


def s5_glu(y, w, b):
    g = jax.nn.gelu(y)
    return g * jax.nn.sigmoid(g @ w + b)


def s5_mixer(u_lat, u_ctx, p, need_ctx):
    B, T, _ = u_lat.shape
    C = u_ctx.shape[1]
    ul = u_lat.astype(jnp.float32).reshape(B, T, S5_GROUPS, S5_GROUP)
    uc = u_ctx.astype(jnp.float32).reshape(B, C, S5_GROUPS, S5_GROUP)
    d_skip = p['s5_d'].astype(jnp.float32)
    y_lat = d_skip * u_lat.astype(jnp.float32)
    y_ctx = d_skip * u_ctx.astype(jnp.float32) if need_ctx else None
    for direction in range(2):
        reverse = direction == 1
        lam_bar, b_bar, c = s5_discretise(
            p['s5_lambda_re'][direction], p['s5_lambda_im'][direction], p['s5_log_dt'][direction],
            p['s5_b_re'][direction], p['s5_b_im'][direction], p['s5_c_re'][direction], p['s5_c_im'][direction])
        hc = s5_states(uc, lam_bar, b_bar, None, reverse)
        h_final = hc[:, 0] if reverse else hc[:, -1]
        hl = s5_states(ul, lam_bar, b_bar, h_final, reverse)
        y_lat = y_lat + s5_readout(c, hl)
        if need_ctx:
            y_ctx = y_ctx + s5_readout(c, hc)
    out_lat = s5_glu(y_lat.astype(u_lat.dtype), p['s5_glu_w'], p['s5_glu_b'])
    out_ctx = s5_glu(y_ctx.astype(u_ctx.dtype), p['s5_glu_w'], p['s5_glu_b']) if need_ctx else None
    return out_lat, out_ctx


def merge_branches(ys, gates, w_branch, w_out):
    g = jax.nn.sigmoid(gates.reshape(gates.shape[:-1] + (N_BRANCH, gates.shape[-1] // N_BRANCH)))
    proj = jnp.einsum('btnw,nwd->btnd', jnp.stack(ys, axis=-2), w_branch)
    return jnp.sum(g * proj, axis=-2) @ w_out


def hybrid_token_mixer(n_lat, n_ctx, p, rows, cols, need_ctx):
    (na_q, na_k, na_v, sw_q, sw_k, sw_v, s5_u, mla_cq, mla_ckv, mla_kr, gates) = split_columns(n_lat @ p['w_in'])
    (na_qc, na_kc, na_vc, sw_qc, sw_kc, sw_vc, s5_uc, mla_cqc, mla_ckvc, mla_krc, gates_c) = split_columns(n_ctx @ p['w_in'])
    na_kc_h, na_vc_h = split_heads(na_kc, NA_HEADS), split_heads(na_vc, NA_HEADS)
    y_na = neighbourhood_attention(split_heads(na_q, NA_HEADS), split_heads(na_k, NA_HEADS),
                                   split_heads(na_v, NA_HEADS), na_kc_h, na_vc_h, p['na_rpb'])
    sw_kc_h, sw_vc_h = split_heads(sw_kc, SWA_KV_HEADS), split_heads(sw_vc, SWA_KV_HEADS)
    y_sw = sliding_window_attention(rope_2d(split_heads(sw_q, SWA_HEADS), rows, cols),
                                    rope_2d(split_heads(sw_k, SWA_KV_HEADS), rows, cols),
                                    split_heads(sw_v, SWA_KV_HEADS), sw_kc_h, sw_vc_h, p['swa_sink'])
    y_s5, y_s5_c = s5_mixer(s5_u, s5_uc, p, need_ctx)
    k_mc, v_mc = mla_keys_values(mla_ckvc, mla_krc, p, None, None)
    k_m, v_m = mla_keys_values(mla_ckv, mla_kr, p, rows, cols)
    y_mla = mla_dense_attention(mla_query(mla_cq, p, rows, cols), k_m, v_m, k_mc, v_mc)
    out_lat = merge_branches([y_na, y_sw, y_s5, y_mla], gates, p['w_branch'], p['w_out'])
    if not need_ctx:
        return out_lat, None
    y_na_c = ctx_attention(split_heads(na_qc, NA_HEADS), na_kc_h, na_vc_h)
    y_sw_c = ctx_attention(split_heads(sw_qc, SWA_HEADS), sw_kc_h, sw_vc_h, p['swa_sink'])
    y_mla_c = ctx_attention(mla_query(mla_cqc, p, None, None), k_mc, v_mc)
    out_ctx = merge_branches([y_na_c, y_sw_c, y_s5_c, y_mla_c], gates_c, p['w_branch'], p['w_out'])
    return out_lat, out_ctx


def setup_inputs(seed: int = 0) -> dict:
    key = jax.random.key(seed)
    ks = iter(jax.random.split(key, 48))

    def nrm(shape, scale=1.0):
        return jax.random.normal(next(ks), shape, jnp.float32) * scale

    def gain(shape):
        return 1.0 + nrm(shape, 0.01)

    D = D_MODEL
    G, P, Cg = S5_GROUPS, S5_STATE, S5_GROUP
    lam_im = jnp.pi * jnp.arange(P, dtype=jnp.float32) + nrm((DEPTH, 2, G, P), 0.01)
    log_dt = jax.random.uniform(next(ks), (DEPTH, 2, G), jnp.float32,
                                math.log(S5_DT_MIN), math.log(S5_DT_MAX))
    return {
        'x': nrm((BATCH, SEQ, D)),
        'c': nrm((BATCH, D)),
        'ctx': nrm((BATCH, CTX_LEN, D)),
        'c_ctx': nrm((D,)),
        'ada_w': nrm((DEPTH, D, N_MOD * D), 0.5 * D ** -0.5),
        'ada_b': nrm((DEPTH, N_MOD * D), 0.02),
        'ffn1_norm': gain((DEPTH, D)),
        'ffn1_w_gate': nrm((DEPTH, D, D_FF), D ** -0.5),
        'ffn1_w_up': nrm((DEPTH, D, D_FF), D ** -0.5),
        'ffn1_w_down': nrm((DEPTH, D_FF, D), D_FF ** -0.5),
        'mix_norm': gain((DEPTH, D)),
        'w_in': nrm((DEPTH, D, IN_COLS), D ** -0.5),
        'na_rpb': nrm((DEPTH, NA_HEADS, 2 * NA_WIN_ROWS - 1, 2 * NA_WIN_COLS - 1), 0.02),
        'swa_sink': nrm((DEPTH, SWA_HEADS), 0.5),
        's5_lambda_re': -0.5 + nrm((DEPTH, 2, G, P), 0.01),
        's5_lambda_im': lam_im,
        's5_log_dt': log_dt,
        's5_b_re': nrm((DEPTH, 2, G, P, Cg), (2 * Cg) ** -0.5),
        's5_b_im': nrm((DEPTH, 2, G, P, Cg), (2 * Cg) ** -0.5),
        's5_c_re': nrm((DEPTH, 2, G, Cg, P), P ** -0.5),
        's5_c_im': nrm((DEPTH, 2, G, Cg, P), P ** -0.5),
        's5_d': nrm((DEPTH, S5_WIDTH)),
        's5_glu_w': nrm((DEPTH, S5_WIDTH, S5_WIDTH), S5_WIDTH ** -0.5),
        's5_glu_b': nrm((DEPTH, S5_WIDTH), 0.02),
        'mla_q_norm': gain((DEPTH, MLA_Q_LORA)),
        'mla_w_uq': nrm((DEPTH, MLA_Q_LORA, MLA_HEADS * (MLA_NOPE + MLA_ROPE)), MLA_Q_LORA ** -0.5),
        'mla_kv_norm': gain((DEPTH, MLA_KV_LORA)),
        'mla_w_ukv': nrm((DEPTH, MLA_KV_LORA, MLA_HEADS * (MLA_NOPE + MLA_V)), MLA_KV_LORA ** -0.5),
        'w_branch': nrm((DEPTH, N_BRANCH, BRANCH_WIDTH, D), BRANCH_WIDTH ** -0.5),
        'w_out': nrm((DEPTH, D, D), D ** -0.5),
        'ffn2_norm': gain((DEPTH, D)),
        'ffn2_w_gate': nrm((DEPTH, D, D_FF), D ** -0.5),
        'ffn2_w_up': nrm((DEPTH, D, D_FF), D ** -0.5),
        'ffn2_w_down': nrm((DEPTH, D_FF, D), D_FF ** -0.5),
        'final_norm': gain((D,)),
    }


def reference(x, c, ctx, c_ctx, ada_w, ada_b, ffn1_norm, ffn1_w_gate, ffn1_w_up, ffn1_w_down,
              mix_norm, w_in, na_rpb, swa_sink, s5_lambda_re, s5_lambda_im, s5_log_dt,
              s5_b_re, s5_b_im, s5_c_re, s5_c_im, s5_d, s5_glu_w, s5_glu_b,
              mla_q_norm, mla_w_uq, mla_kv_norm, mla_w_ukv, w_branch, w_out,
              ffn2_norm, ffn2_w_gate, ffn2_w_up, ffn2_w_down, final_norm):
    B, T, D = x.shape
    pos = jnp.arange(T)
    rows = pos // GRID_W
    cols = pos % GRID_W
    h, hc = x, ctx
    silu_c, silu_cc = jax.nn.silu(c), jax.nn.silu(c_ctx)
    for l in range(DEPTH):
        need_ctx = l < DEPTH - 1
        mod = (silu_c @ ada_w[l] + ada_b[l]).reshape(B, N_MOD, 1, D)
        modc = (silu_cc @ ada_w[l] + ada_b[l]).reshape(N_MOD, D)
        h = macaron_half_ffn(h, mod[:, 0], mod[:, 1], mod[:, 2], ffn1_norm[l],
                             ffn1_w_gate[l], ffn1_w_up[l], ffn1_w_down[l])
        hc = macaron_half_ffn(hc, modc[0], modc[1], modc[2], ffn1_norm[l],
                              ffn1_w_gate[l], ffn1_w_up[l], ffn1_w_down[l])
        p = {'w_in': w_in[l], 'na_rpb': na_rpb[l], 'swa_sink': swa_sink[l],
             's5_lambda_re': s5_lambda_re[l], 's5_lambda_im': s5_lambda_im[l], 's5_log_dt': s5_log_dt[l],
             's5_b_re': s5_b_re[l], 's5_b_im': s5_b_im[l], 's5_c_re': s5_c_re[l], 's5_c_im': s5_c_im[l],
             's5_d': s5_d[l], 's5_glu_w': s5_glu_w[l], 's5_glu_b': s5_glu_b[l],
             'mla_q_norm': mla_q_norm[l], 'mla_w_uq': mla_w_uq[l],
             'mla_kv_norm': mla_kv_norm[l], 'mla_w_ukv': mla_w_ukv[l],
             'w_branch': w_branch[l], 'w_out': w_out[l]}
        n_lat = modulate(rms_norm(h, mix_norm[l]), mod[:, 3], mod[:, 4])
        n_ctx = modulate(rms_norm(hc, mix_norm[l]), modc[3], modc[4])
        y_lat, y_ctx = hybrid_token_mixer(n_lat, n_ctx, p, rows, cols, need_ctx)
        h = h + mod[:, 5] * y_lat
        h = macaron_half_ffn(h, mod[:, 6], mod[:, 7], mod[:, 8], ffn2_norm[l],
                             ffn2_w_gate[l], ffn2_w_up[l], ffn2_w_down[l])
        if need_ctx:
            hc = hc + modc[5] * y_ctx
            hc = macaron_half_ffn(hc, modc[6], modc[7], modc[8], ffn2_norm[l],
                                  ffn2_w_gate[l], ffn2_w_up[l], ffn2_w_down[l])
    return rms_norm(h, final_norm)
```

```cpp
#include <hip/hip_runtime.h>
#include <hip/hip_cooperative_groups.h>
#include <cstdio>
#include <cstdint>
namespace cg = cooperative_groups;

namespace pg8 {
#define PG8_LAS __attribute__((address_space(3)))
typedef unsigned short bf16_t;
typedef short bf16x8 __attribute__((ext_vector_type(8)));
typedef short s16x4 __attribute__((ext_vector_type(4)));
typedef float f32x4 __attribute__((ext_vector_type(4)));
typedef unsigned u32x4 __attribute__((ext_vector_type(4)));
typedef unsigned u32x2 __attribute__((ext_vector_type(2)));
constexpr int BM = 256, BK = 64, HALF = 128, HTB = HALF * BK * 2, STAGE_BYTES = 8 * HTB, NXCD = 8, WGM = 8;

__host__ __device__ __forceinline__ int lds_byte(int r, int c) { const int st = (r >> 4) * 2 + (c >> 5), rr = r & 15, cc = c & 31, ob = rr * 64 + cc * 2; return st * 1024 + (ob ^ (((ob >> 9) & 1) << 5)); }
__host__ __device__ __forceinline__ void stage_rc(int b, int& R, int& C) { const int st = b / 1024, sb = b % 1024, swz = sb ^ (((sb >> 9) & 1) << 5); R = (st >> 1) * 16 + swz / 64; C = (st & 1) * 32 + (swz % 64) / 2; }

__host__ __device__ __forceinline__ int perm32(int rho) { const int n = rho >> 4, i = rho & 15; return 8 * (i >> 2) + 4 * n + (i & 3); }
struct Unit { int pm, pn; };
struct Gemm { const bf16_t* A; int lda; const bf16_t* Bt; int M, N, K; int a_div; int a_stride; };

struct StaticOrder {
    int nM, nN, nwg, G, c;
    __host__ __device__ void init(int M, int N, int G_, int c_) { nM = M / BM; nN = N / BM; nwg = nM * nN; G = G_; c = c_; }
    __host__ __device__ bool next(int i, Unit& u) const {
        const long L = (long)i * G + c; if (L >= nwg) return false;
        int wgid = (int)L; { const int q = nwg / NXCD, r = nwg % NXCD, xcd = wgid % NXCD, off = wgid / NXCD; wgid = (xcd < r ? xcd * (q + 1) : r * (q + 1) + (xcd - r) * q) + off; }
        const int nig = WGM * nN, gid = wgid / nig, fm = gid * WGM, gsz = (nM - fm) < WGM ? (nM - fm) : WGM;
        u.pm = fm + ((wgid % nig) % gsz); u.pn = (wgid % nig) / gsz; return true;
    }
};
__device__ __forceinline__ unsigned cvt_pk_bf16(float lo, float hi) { unsigned r; asm volatile("v_cvt_pk_bf16_f32 %0, %1, %2" : "=v"(r) : "v"(lo), "v"(hi)); return r; }

template <class Epi, class Sched, bool ALIGN_EPI = false, bool SP2 = false>
__device__ __forceinline__ void gemm_phase(const int TID, PG8_LAS unsigned char* lds, const Gemm g, const Sched& S, const Epi& E) {
    const int tid = TID, wid = __builtin_amdgcn_readfirstlane(tid >> 6), lane = tid & 63, wr = wid >> 2, wc = wid & 3, fr = lane & 15, fq = lane >> 4;
    int K = g.K, lda = g.lda; asm volatile("" : "+s"(K), "+s"(lda));
    const int nt = K / BK;
    unsigned voffA[2], voffB[2];
#pragma unroll
    for (int i = 0; i < 2; ++i) { int R, C; stage_rc(tid * 16 + i * 8192, R, C);
        const int Rb = Epi::PERM ? ((R & ~31) + perm32(R & 31)) : R;
        voffA[i] = (unsigned)(R * lda + C) * 2u; voffB[i] = (unsigned)(Rb * K + C) * 2u; }
    const size_t kstep = (size_t)(BK * 2);
    const size_t hstepA = (size_t)HALF * lda * 2, hstepB = (size_t)HALF * K * 2;
    const size_t tstepA = 2 * hstepA, tstepB = 2 * hstepB;
    const unsigned ldsw = (unsigned)wid * 1024u;
    const int aoff = lds_byte(wr * 64 + fr, fq * 8), boff = lds_byte(wc * 32 + fr, fq * 8);
#define PG8_ABASE(u) ((const char*)g.A + (size_t)(u).pm * tstepA + (g.a_div ? (size_t)((u).pn / g.a_div) * (size_t)g.a_stride * 2 : (size_t)0))
#define PG8_SA(b, h) (((b) * 2 + (h)) * HTB)
#define PG8_SB(b, h) ((4 + (b) * 2 + (h)) * HTB)
#define PG8_STAGE(bufoff, gbase, voff) do { _Pragma("unroll") for (int _i = 0; _i < 2; ++_i) \
        __builtin_amdgcn_global_load_lds((const unsigned*)((const char*)(gbase) + (voff)[_i]), (PG8_LAS unsigned*)(lds + (bufoff) + ldsw + _i * 8192), 16, 0, 0); } while (0)
#define PG8_LDA(dst, b, h) do { _Pragma("unroll") for (int m = 0; m < 4; ++m) _Pragma("unroll") for (int k = 0; k < 2; ++k) dst[m][k] = *(const PG8_LAS bf16x8*)(lds + PG8_SA(b, h) + aoff + m * 2048 + k * 1024); } while (0)
#define PG8_LDB(dst, b, h) do { _Pragma("unroll") for (int n = 0; n < 2; ++n) _Pragma("unroll") for (int k = 0; k < 2; ++k) dst[n][k] = *(const PG8_LAS bf16x8*)(lds + PG8_SB(b, h) + boff + n * 2048 + k * 1024); } while (0)
#define PG8_MMA(ai, bj, At, Bt) do { __builtin_amdgcn_s_setprio(1); _Pragma("unroll") for (int m = 0; m < 4; ++m) _Pragma("unroll") for (int n = 0; n < 2; ++n) _Pragma("unroll") for (int k = 0; k < 2; ++k) \
        acc[ai][bj][m][n] = __builtin_amdgcn_mfma_f32_16x16x32_bf16(Bt[n][k], At[m][k], acc[ai][bj][m][n], 0, 0, 0); __builtin_amdgcn_s_setprio(0); } while (0)
#define PG8_WAIT_V(n) asm volatile("s_waitcnt vmcnt(" #n ")" ::: "memory")
#define PG8_WAIT_L(n) asm volatile("s_waitcnt lgkmcnt(" #n ")" ::: "memory")
#define PG8_BAR __builtin_amdgcn_s_barrier()
#define PG8_SCHED __builtin_amdgcn_sched_barrier(0)
    Unit cur, nxt; int ui = 0;
    if (!S.next(0, cur)) return;
    f32x4 acc[2][2][4][2];
#pragma unroll
    for (int a = 0; a < 2; ++a)
#pragma unroll
        for (int b = 0; b < 2; ++b)
#pragma unroll
            for (int m = 0; m < 4; ++m)
#pragma unroll
                for (int n = 0; n < 2; ++n) acc[a][b][m][n] = (f32x4){0.f, 0.f, 0.f, 0.f};
    bf16x8 At[4][2], B0[2][2], B1[2][2];
    const char* cA = PG8_ABASE(cur); const char* cB = (const char*)g.Bt + (size_t)cur.pn * tstepB;
    if constexpr (SP2) {
        PG8_STAGE(PG8_SB(0, 0), cB, voffB); PG8_STAGE(PG8_SB(0, 1), cB + hstepB, voffB); PG8_STAGE(PG8_SA(0, 0), cA, voffA); PG8_STAGE(PG8_SA(0, 1), cA + hstepA, voffA);
        if (wr == 1) PG8_BAR;
        PG8_WAIT_V(2); PG8_BAR;
        PG8_STAGE(PG8_SB(1, 0), cB + kstep, voffB); PG8_STAGE(PG8_SA(1, 0), cA + kstep, voffA); PG8_STAGE(PG8_SB(1, 1), cB + hstepB + kstep, voffB);
        PG8_WAIT_V(6); PG8_BAR;
    } else {
        PG8_STAGE(PG8_SB(0, 0), cB, voffB); PG8_STAGE(PG8_SA(0, 0), cA, voffA); PG8_STAGE(PG8_SB(0, 1), cB + hstepB, voffB); PG8_STAGE(PG8_SA(0, 1), cA + hstepA, voffA);
        if (wr == 1) PG8_BAR;
        PG8_WAIT_V(4); PG8_BAR;
        PG8_STAGE(PG8_SB(1, 0), cB + kstep, voffB); PG8_STAGE(PG8_SA(1, 0), cA + kstep, voffA); PG8_STAGE(PG8_SB(1, 1), cB + hstepB + kstep, voffB);
        PG8_WAIT_V(6); PG8_BAR;
    }
    for (;;) {
        const bool has_next = S.next(ui + 1, nxt);
        const char* nA = has_next ? PG8_ABASE(nxt) : cA; const char* nB = has_next ? (const char*)g.Bt + (size_t)nxt.pn * tstepB : cB;
        for (int t = 0; t < nt; t += 2) {
            const bool last = (t == nt - 2);
            const char* a1 = cA + (size_t)(t + 1) * kstep;
            const char* a2 = last ? nA : cA + (size_t)(t + 2) * kstep; const char* b2 = last ? nB : cB + (size_t)(t + 2) * kstep;
            const char* a3 = a2 + kstep; const char* b3 = b2 + kstep;
            if constexpr (SP2) {
            PG8_LDB(B0, 0, 0); PG8_LDB(B1, 0, 1); PG8_SCHED; PG8_LDA(At, 0, 0); PG8_STAGE(PG8_SA(1, 1), a1 + hstepA, voffA);
            PG8_WAIT_V(8); PG8_WAIT_L(0); PG8_BAR; PG8_MMA(0, 0, At, B0); PG8_MMA(0, 1, At, B1); PG8_BAR; PG8_SCHED;
            PG8_LDA(At, 0, 1); PG8_STAGE(PG8_SB(0, 0), b2, voffB); PG8_STAGE(PG8_SB(0, 1), b2 + hstepB, voffB); PG8_STAGE(PG8_SA(0, 0), a2, voffA);
            PG8_WAIT_V(8); PG8_WAIT_L(0); PG8_BAR; PG8_MMA(1, 0, At, B0); PG8_MMA(1, 1, At, B1); PG8_BAR; PG8_SCHED;
            PG8_LDB(B0, 1, 0); PG8_LDB(B1, 1, 1); PG8_SCHED; PG8_LDA(At, 1, 0); PG8_STAGE(PG8_SA(0, 1), a2 + hstepA, voffA);
            PG8_WAIT_V(8); PG8_WAIT_L(0); PG8_BAR; PG8_MMA(0, 0, At, B0); PG8_MMA(0, 1, At, B1); PG8_BAR; PG8_SCHED;
            PG8_LDA(At, 1, 1); PG8_STAGE(PG8_SB(1, 0), b3, voffB); PG8_STAGE(PG8_SB(1, 1), b3 + hstepB, voffB); PG8_STAGE(PG8_SA(1, 0), a3, voffA);
            PG8_WAIT_V(8); PG8_WAIT_L(0); PG8_BAR; PG8_MMA(1, 0, At, B0); PG8_MMA(1, 1, At, B1); PG8_BAR; PG8_SCHED;
            } else {
            PG8_LDB(B0, 0, 0); PG8_SCHED; PG8_LDA(At, 0, 0); PG8_STAGE(PG8_SA(1, 1), a1 + hstepA, voffA);
            PG8_WAIT_L(8); PG8_BAR; PG8_WAIT_L(0); PG8_MMA(0, 0, At, B0); PG8_BAR; PG8_SCHED;
            PG8_LDB(B1, 0, 1); PG8_STAGE(PG8_SB(0, 0), b2, voffB);
            PG8_BAR; PG8_WAIT_L(0); PG8_MMA(0, 1, At, B1); PG8_BAR;
            PG8_LDA(At, 0, 1); PG8_STAGE(PG8_SA(0, 0), a2, voffA);
            PG8_BAR; PG8_WAIT_L(0); PG8_MMA(1, 0, At, B0); PG8_BAR; PG8_SCHED;
            PG8_STAGE(PG8_SB(0, 1), b2 + hstepB, voffB);
            PG8_WAIT_V(6); PG8_BAR; PG8_MMA(1, 1, At, B1); PG8_BAR;
            PG8_LDB(B0, 1, 0); PG8_SCHED; PG8_LDA(At, 1, 0); PG8_STAGE(PG8_SA(0, 1), a2 + hstepA, voffA);
            PG8_WAIT_L(8); PG8_BAR; PG8_WAIT_L(0); PG8_MMA(0, 0, At, B0); PG8_BAR; PG8_SCHED;
            PG8_LDB(B1, 1, 1); PG8_STAGE(PG8_SB(1, 0), b3, voffB);
            PG8_BAR; PG8_WAIT_L(0); PG8_MMA(0, 1, At, B1); PG8_BAR;
            PG8_LDA(At, 1, 1); PG8_STAGE(PG8_SA(1, 0), a3, voffA);
            PG8_BAR; PG8_WAIT_L(0); PG8_MMA(1, 0, At, B0); PG8_BAR; PG8_SCHED;
            PG8_STAGE(PG8_SB(1, 1), b3 + hstepB, voffB);
            PG8_WAIT_V(6); PG8_BAR; PG8_MMA(1, 1, At, B1); PG8_BAR;
            }
        }
        if constexpr (ALIGN_EPI) { if (wr == 0) PG8_BAR; }
        E(acc, cur, wr, wc, fr, fq);
        if (!has_next) break;
#pragma unroll
        for (int a = 0; a < 2; ++a)
#pragma unroll
            for (int b = 0; b < 2; ++b)
#pragma unroll
                for (int m = 0; m < 4; ++m)
#pragma unroll
                    for (int n = 0; n < 2; ++n) acc[a][b][m][n] = (f32x4){0.f, 0.f, 0.f, 0.f};
        cur = nxt; cA = nA; cB = nB; ++ui;
        if constexpr (ALIGN_EPI) { if (wr == 1) PG8_BAR; }
    }
    PG8_WAIT_V(0);
    if constexpr (!ALIGN_EPI) { if (wr == 0) PG8_BAR; }
    PG8_BAR;
#undef PG8_ABASE
#undef PG8_SA
#undef PG8_SB
#undef PG8_STAGE
#undef PG8_LDA
#undef PG8_LDB
#undef PG8_MMA
#undef PG8_WAIT_V
#undef PG8_WAIT_L
#undef PG8_BAR
#undef PG8_SCHED
}
}

using pg8::bf16_t; using pg8::bf16x8; using pg8::s16x4; using pg8::f32x4; using pg8::u32x4; using pg8::u32x2; using pg8::cvt_pk_bf16; using pg8::Unit;

constexpr int D = 1024, BATCH = 4, SEQ = 4096, CTX = 256, DFF = 2816, NMOD = 9;
constexpr int M_LAT = BATCH * SEQ, M_ALL = M_LAT + BATCH * CTX;
constexpr int WA_N = 3328, INCOLS = 7328;
constexpr int C_NAQ = 0, C_NAK = 512, C_NAV = 1024, C_SWQ = 1536, C_SWK = 2048, C_SWV = 2176, C_S5U = 2304, C_CQ = 2816, C_CKV = 3072, C_KR = 3200;
constexpr float EPS = 1e-6f, LOG2E = 1.4426950408889634f;
constexpr int NTHREADS = 512, NWAVES = 8;
constexpr int LDS_BYTES = 147456;

constexpr size_t MiB = 1u << 20;
constexpr size_t WS_MOD = 0;
constexpr size_t WS_CTL = 512 * 1024, CTL_BYTES = 16384;
constexpr size_t WS_HC = 1 * MiB;
constexpr size_t WS_S5 = 5 * MiB;
constexpr size_t WS_WB = 14 * MiB;
constexpr size_t WB_GU = 0, WB_DN = 11 * MiB, WB_INA = WB_DN + 5632 * 1024, WB_G = WB_INA + 6656 * 1024, WB_UQ = WB_G + 8 * MiB,
                 WB_UKV = WB_UQ + 384 * 1024, WB_BR = WB_UKV + 256 * 1024, WB_OUT = WB_BR + 4 * MiB, WB_GLU = WB_OUT + 2 * MiB, WB_END = WB_GLU + 512 * 1024;
static_assert(WB_END <= 39 * MiB, "weights");
constexpr size_t WS_G5 = 53 * MiB;
constexpr size_t WS_XN = 70 * MiB;
constexpr size_t WS_Y = 104 * MiB;
constexpr size_t WS_BIG = 172 * MiB;
constexpr size_t BIG_WA = 0, BIG_MLAQ = (size_t)M_ALL * WA_N * 2, BIG_MLAKV = BIG_MLAQ + (size_t)M_ALL * 768 * 2, BIG_END = BIG_MLAKV + (size_t)M_ALL * 1024 * 2;
constexpr size_t BIG_P = 0, BIG_MB = (size_t)M_ALL * 4096 * 2;
static_assert(BIG_MB + (size_t)M_ALL * 1024 * 2 <= BIG_END, "overlay");
constexpr size_t WS_KERN = WS_BIG + BIG_END;
constexpr size_t WS_SBH = WS_KERN + 2 * MiB;
constexpr size_t WS_END = WS_SBH + 5 * MiB;
constexpr int KSPLIT = 16;

#define DEV __device__ __forceinline__
DEV float bf2f(unsigned short v) { return __uint_as_float((unsigned)v << 16); }
DEV float bflo(unsigned v) { return __uint_as_float(v << 16); }
DEV float bfhi(unsigned v) { return __uint_as_float(v & 0xffff0000u); }
DEV unsigned short f2bf(float f) { return (unsigned short)(cvt_pk_bf16(f, 0.f) & 0xffffu); }
DEV float sigmoidf_(float x) { return __builtin_amdgcn_rcpf(1.f + __expf(-x)); }
DEV float shflx(float v, int lane, int m) { return __int_as_float(__builtin_amdgcn_ds_bpermute((lane ^ m) << 2, __float_as_int(v))); }
DEV float wave_sum(float v, int lane) {
#pragma unroll
    for (int o = 1; o < 64; o <<= 1) v += shflx(v, lane, o);
    return v;
}
DEV int clampi(int v, int lo, int hi) { return v < lo ? lo : (v > hi ? hi : v); }

struct KP {
    const float* in[35];
    float* out; unsigned char* ws;
    int ph_lo, ph_hi;
};
typedef const __attribute__((address_space(4))) KP* KPP;

struct EpiSwiglu {
    static constexpr bool PERM = true;
    bf16_t* O;
    DEV void operator()(const f32x4 (&acc)[2][2][4][2], const Unit& u, int wr, int wc, int fr, int fq) const {
#pragma unroll
        for (int ai = 0; ai < 2; ++ai)
#pragma unroll
            for (int m = 0; m < 4; ++m) {
                const int row = u.pm * 256 + ai * 128 + wr * 64 + m * 16 + fr;
                float v[8];
#pragma unroll
                for (int n = 0; n < 2; ++n) { const f32x4 g = acc[ai][0][m][n], up = acc[ai][1][m][n];
#pragma unroll
                    for (int j = 0; j < 4; ++j) v[n * 4 + j] = g[j] * sigmoidf_(g[j]) * up[j]; }
                u32x4 w; w.x = cvt_pk_bf16(v[0], v[1]); w.y = cvt_pk_bf16(v[2], v[3]); w.z = cvt_pk_bf16(v[4], v[5]); w.w = cvt_pk_bf16(v[6], v[7]);
                *(u32x4*)(O + (size_t)row * DFF + u.pn * 128 + wc * 32 + fq * 8) = w;
            }
    }
};
struct EpiResid {
    static constexpr bool PERM = false;
    const float* in_lat; const float* in_ctx; float* out_lat; float* out_ctx; const float* gate;   float s;
    DEV void operator()(const f32x4 (&acc)[2][2][4][2], const Unit& u, int wr, int wc, int fr, int fq) const {
        const bool lat = u.pm < 64; const int v = lat ? (u.pm >> 4) : 4;
        const float* gv = gate + (size_t)v * 9 * 1024;
        const float* ib = lat ? in_lat : in_ctx - (size_t)M_LAT * D; float* ob = lat ? out_lat : out_ctx - (size_t)M_LAT * D;
#pragma unroll
        for (int bj = 0; bj < 2; ++bj)
#pragma unroll
            for (int n = 0; n < 2; ++n) {
                const int col = u.pn * 256 + bj * 128 + wc * 32 + n * 16 + fq * 4;
                const f32x4 g4 = *(const f32x4*)(gv + col) * s;
#pragma unroll
                for (int ai = 0; ai < 2; ++ai)
#pragma unroll
                    for (int m = 0; m < 4; ++m) {
                        const size_t off = (size_t)(u.pm * 256 + ai * 128 + wr * 64 + m * 16 + fr) * D + col;
                        const f32x4 b4 = *(const f32x4*)(ib + off);
                        *(f32x4*)(ob + off) = b4 + g4 * acc[ai][bj][m][n];
                    }
            }
    }
};
struct EpiStore {
    static constexpr bool PERM = true;
    bf16_t* O; int ldc;
    DEV void operator()(const f32x4 (&acc)[2][2][4][2], const Unit& u, int wr, int wc, int fr, int fq) const {
#pragma unroll
        for (int ai = 0; ai < 2; ++ai)
#pragma unroll
            for (int m = 0; m < 4; ++m) {
                bf16_t* rp = O + (size_t)(u.pm * 256 + ai * 128 + wr * 64 + m * 16 + fr) * ldc + u.pn * 256 + wc * 32 + fq * 8;
#pragma unroll
                for (int bj = 0; bj < 2; ++bj) { const f32x4 v0 = acc[ai][bj][m][0], v1 = acc[ai][bj][m][1];
                    u32x4 w; w.x = cvt_pk_bf16(v0[0], v0[1]); w.y = cvt_pk_bf16(v0[2], v0[3]); w.z = cvt_pk_bf16(v1[0], v1[1]); w.w = cvt_pk_bf16(v1[2], v1[3]);
                    *(u32x4*)(rp + bj * 128) = w; }
            }
    }
};
struct EpiGlu {
    static constexpr bool PERM = true;
    const bf16_t* G5; const float* bias; bf16_t* Y;
    DEV void operator()(const f32x4 (&acc)[2][2][4][2], const Unit& u, int wr, int wc, int fr, int fq) const {
#pragma unroll
        for (int bj = 0; bj < 2; ++bj) {
            const int col = u.pn * 256 + bj * 128 + wc * 32 + fq * 8;
            const f32x4 b0 = *(const f32x4*)(bias + col), b1 = *(const f32x4*)(bias + col + 4);
#pragma unroll
            for (int ai = 0; ai < 2; ++ai)
#pragma unroll
                for (int m = 0; m < 4; ++m) {
                    const int row = u.pm * 256 + ai * 128 + wr * 64 + m * 16 + fr;
                    const u32x4 gw = *(const u32x4*)(G5 + (size_t)row * 512 + col);
                    const f32x4 a0 = acc[ai][bj][m][0] + b0, a1 = acc[ai][bj][m][1] + b1;
                    u32x4 w;
                    w.x = cvt_pk_bf16(bflo(gw.x) * sigmoidf_(a0[0]), bfhi(gw.x) * sigmoidf_(a0[1])); w.y = cvt_pk_bf16(bflo(gw.y) * sigmoidf_(a0[2]), bfhi(gw.y) * sigmoidf_(a0[3]));
                    w.z = cvt_pk_bf16(bflo(gw.z) * sigmoidf_(a1[0]), bfhi(gw.z) * sigmoidf_(a1[1])); w.w = cvt_pk_bf16(bflo(gw.w) * sigmoidf_(a1[2]), bfhi(gw.w) * sigmoidf_(a1[3]));
                    *(u32x4*)(Y + (size_t)row * 2048 + 1024 + col) = w;
                }
        }
    }
};
struct EpiMerge {
    static constexpr bool PERM = false;
    const bf16_t* P; bf16_t* MB;
    DEV void operator()(const f32x4 (&acc)[2][2][4][2], const Unit& u, int wr, int wc, int fr, int fq) const {
        const int c = u.pn * 64 + wc * 16 + fq * 4;
#pragma unroll
        for (int ai = 0; ai < 2; ++ai)
#pragma unroll
            for (int m = 0; m < 4; ++m) {
                const int row = u.pm * 256 + ai * 128 + wr * 64 + m * 16 + fr;
                const bf16_t* pr = P + (size_t)row * 4096 + c;
                f32x4 v = (f32x4){0.f, 0.f, 0.f, 0.f};
#pragma unroll
                for (int bj = 0; bj < 2; ++bj)
#pragma unroll
                    for (int n = 0; n < 2; ++n) {
                        const u32x2 pw = *(const u32x2*)(pr + (2 * bj + n) * 1024); const f32x4 a = acc[ai][bj][m][n];
                        v[0] += bflo(pw.x) * sigmoidf_(a[0]); v[1] += bfhi(pw.x) * sigmoidf_(a[1]); v[2] += bflo(pw.y) * sigmoidf_(a[2]); v[3] += bfhi(pw.y) * sigmoidf_(a[3]);
                    }
                u32x2 w; w.x = cvt_pk_bf16(v[0], v[1]); w.y = cvt_pk_bf16(v[2], v[3]);
                *(u32x2*)(MB + (size_t)row * D + c) = w;
            }
    }
};

DEV const float* wsrc(const float* src, const float* src2, int map, int n) {
    switch (map) {
        case 1: { const int t = n >> 8, r = n & 255; return (r < 128) ? src + t * 128 + r : src2 + t * 128 + r - 128; }
        case 2: { if (n < 3232) return src + n; return nullptr; }
        case 3: { const int pn = n >> 8, loc = n & 255, bj = loc >> 7, wc = (loc >> 5) & 3, n16 = (loc >> 4) & 1, i = loc & 15; return src + 3232 + (2 * bj + n16) * 1024 + pn * 64 + wc * 16 + i; }
        case 5: { const int br = n >> 10, dd = n & 1023; return src + (size_t)br * 512 * 1024 + dd; }
        default: return src + n;
    }
}
DEV void wprep_item(const float* src, const float* src2, bf16_t* dst, int srcN, int K, int map, int item, float* scr  , int lane) {
    const int nkb = K / 64, nb = item / nkb, kb = item % nkb, k0 = kb * 64, n0 = nb * 64;
    const float* cp = wsrc(src, src2, map, n0 + (lane & 15) * 4);
    f32x4 v[16];
#pragma unroll
    for (int i = 0; i < 16; ++i) { const int kk = 4 * i + (lane >> 4); v[i] = cp ? *(const f32x4*)(cp + (size_t)(k0 + kk) * srcN) : (f32x4){0.f, 0.f, 0.f, 0.f}; }
#pragma unroll
    for (int i = 0; i < 16; ++i) { float* w = scr + (4 * i + (lane >> 4)) * 65 + (lane & 15) * 4; w[0] = v[i][0]; w[1] = v[i][1]; w[2] = v[i][2]; w[3] = v[i][3]; }
    asm volatile("s_waitcnt lgkmcnt(0)" ::: "memory");
    const int c = lane & 7;
#pragma unroll
    for (int j = 0; j < 8; ++j) { const int n = (lane >> 3) + 8 * j; const float* s = scr + (8 * c) * 65 + n;
        u32x4 o; o.x = cvt_pk_bf16(s[0 * 65], s[1 * 65]); o.y = cvt_pk_bf16(s[2 * 65], s[3 * 65]); o.z = cvt_pk_bf16(s[4 * 65], s[5 * 65]); o.w = cvt_pk_bf16(s[6 * 65], s[7 * 65]);
        *(u32x4*)(dst + (size_t)(n0 + n) * K + k0 + 8 * c) = o; }
    asm volatile("s_waitcnt lgkmcnt(0)" ::: "memory");
}
DEV void wprep_phase(const int TID, KPP p, unsigned char* lds, int layer, int which) {
    const int lane = TID & 63, wid = __builtin_amdgcn_readfirstlane(TID >> 6);
    __syncthreads();
    float* scr = (float*)(lds + wid * 16640);
    const int gw = wid * gridDim.x + blockIdx.x, NGW = gridDim.x * NWAVES;
    unsigned char* wbp = p->ws + WS_WB;
    const int total = which ? 2112 : 4880;
    for (int it0 = gw; it0 < total; it0 += NGW) {
        int it = __builtin_amdgcn_readfirstlane(it0);
        const float* src; const float* src2; bf16_t* dst; int srcN, K, map;
#define WJ(cnt, S, S2, OFF, SRCN, KK, MAP) if (it < (cnt)) { src = (S); src2 = (S2); dst = (bf16_t*)(wbp + (OFF)); srcN = (SRCN); K = (KK); map = (MAP); } else { it -= (cnt);
        if (which == 0) {
            WJ(1408, p->in[7] + (size_t)layer * D * DFF, p->in[8] + (size_t)layer * D * DFF, WB_GU, DFF, D, 1)
            WJ(704, p->in[9] + (size_t)layer * DFF * D, src, WB_DN, D, DFF, 0)
            WJ(832, p->in[11] + (size_t)layer * D * INCOLS, src, WB_INA, INCOLS, D, 2)
            WJ(1024, p->in[11] + (size_t)layer * D * INCOLS, src, WB_G, INCOLS, D, 3)
            WJ(48, p->in[25] + (size_t)layer * 256 * 768, src, WB_UQ, 768, 256, 0)
            WJ(32, p->in[27] + (size_t)layer * 128 * 1024, src, WB_UKV, 1024, 128, 0)
            WJ(512, p->in[28] + (size_t)layer * 4 * 512 * 1024, src, WB_BR, 1024, 512, 5)
            WJ(256, p->in[29] + (size_t)layer * D * D, src, WB_OUT, D, D, 0)
            { src = p->in[22] + (size_t)layer * 512 * 512; src2 = src; dst = (bf16_t*)(wbp + WB_GLU); srcN = 512; K = 512; map = 0; }
            }}}}}}}}
        } else {
            WJ(1408, p->in[31] + (size_t)layer * D * DFF, p->in[32] + (size_t)layer * D * DFF, WB_GU, DFF, D, 1)
            { src = p->in[33] + (size_t)layer * DFF * D; src2 = src; dst = (bf16_t*)(wbp + WB_DN); srcN = D; K = DFF; map = 0; }
            }
        }
#undef WJ
        wprep_item(src, src2, dst, srcN, K, map, it, scr, lane);
    }
    __syncthreads();
}

DEV void modp_phase(const int TID, KPP p, unsigned char* lds) {
    float* S = (float*)lds;
    const int tid = TID, lane = tid & 63, wid = tid >> 6;
    __syncthreads();
    for (int i = tid; i < 5 * 1024; i += NTHREADS) { const float x = (i < 4096) ? p->in[1][i] : p->in[3][i - 4096]; S[i] = x * sigmoidf_(x); }
    __syncthreads();
    float* MOD = (float*)(p->ws + WS_MOD);
    const int gw = wid * gridDim.x + blockIdx.x, NGW = gridDim.x * NWAVES;
    for (int it = gw; it < 2 * 144 * KSPLIT; it += NGW) {
        const int ks = it % KSPLIT, jb = (it / KSPLIT) % 144, l = it / (KSPLIT * 144);
        const float* W = p->in[4] + (size_t)l * D * 9216 + jb * 64 + lane;
        float a0 = 0.f, a1 = 0.f, a2 = 0.f, a3 = 0.f, a4 = 0.f;
#pragma unroll 8
        for (int kk = 0; kk < 64; ++kk) { const int k = ks * 64 + kk; const float w = W[(size_t)k * 9216];
            a0 += S[k] * w; a1 += S[1024 + k] * w; a2 += S[2048 + k] * w; a3 += S[3072 + k] * w; a4 += S[4096 + k] * w; }
        float* o = MOD + (size_t)l * 5 * 9216 + jb * 64 + lane;
        const float bs = (ks == 0) ? p->in[5][l * 9216 + jb * 64 + lane] : 0.f;
        atomicAdd(o, a0 + bs); atomicAdd(o + 9216, a1 + bs); atomicAdd(o + 2 * 9216, a2 + bs); atomicAdd(o + 3 * 9216, a3 + bs); atomicAdd(o + 4 * 9216, a4 + bs);
    }
    __syncthreads();
}
DEV void norm_phase(const int TID, KPP p, const float* hlat, const float* hctx, const float* w, const float* modl  , int ishift, int nrows) {
    bf16_t* XN = (bf16_t*)(p->ws + WS_XN);
    const int lane = TID & 63, wid = TID >> 6;
    const int gw = wid * gridDim.x + blockIdx.x, NGW = gridDim.x * NWAVES;
    for (int r = gw; r < nrows; r += NGW) {
        const float* xr = (r < M_LAT) ? hlat + (size_t)r * D : hctx + (size_t)(r - M_LAT) * D;
        const int v = (r < M_LAT) ? (r >> 12) : 4;
        const float* sh = modl + ((size_t)v * 9 + ishift) * 1024; const float* sc = sh + 1024;
        f32x4 x[4]; float ss = 0.f;
#pragma unroll
        for (int j = 0; j < 4; ++j) { x[j] = *(const f32x4*)(xr + j * 256 + lane * 4); ss += x[j][0] * x[j][0] + x[j][1] * x[j][1] + x[j][2] * x[j][2] + x[j][3] * x[j][3]; }
        const float rs = rsqrtf(wave_sum(ss, lane) * (1.f / D) + EPS);
#pragma unroll
        for (int j = 0; j < 4; ++j) {
            const int c = j * 256 + lane * 4;
            const f32x4 w4 = *(const f32x4*)(w + c), s4 = *(const f32x4*)(sh + c), c4 = *(const f32x4*)(sc + c);
            const f32x4 y = x[j] * rs * w4 * (c4 + 1.f) + s4;
            u32x2 o; o.x = cvt_pk_bf16(y[0], y[1]); o.y = cvt_pk_bf16(y[2], y[3]);
            *(u32x2*)(XN + (size_t)r * D + c) = o;
        }
    }
}
DEV void rope_inplace(bf16_t* x1p, bf16_t* x2p, float pos, float invf) {
    const float ang = pos * invf, cs = __cosf(ang), sn = __sinf(ang);
    const float a = bf2f(*x1p), b = bf2f(*x2p);
    *x1p = f2bf(a * cs - b * sn); *x2p = f2bf(b * cs + a * sn);
}
DEV void mlanorm_phase(const int TID, KPP p, const float* qw, const float* kvw) {
    bf16_t* WA = (bf16_t*)(p->ws + WS_BIG + BIG_WA);
    const int lane = TID & 63, wid = TID >> 6;
    const int gw = wid * gridDim.x + blockIdx.x, NGW = gridDim.x * NWAVES;
    const bool ract = lane < 42;
    int rbase, rxoff, ri0, rpt; float rfd;
    if (lane < 32) { const int hd = lane >> 2, hf = lane & 1; rpt = (lane >> 1) & 1; rbase = C_SWQ + hd * 64 + rpt * 32 + hf * 8; rxoff = 16; ri0 = hf * 8; rfd = 13.287712379549449f / 16.f; }
    else if (lane < 40) { const int l2 = lane - 32, hd = l2 >> 2, hf = l2 & 1; rpt = (l2 >> 1) & 1; rbase = C_SWK + hd * 64 + rpt * 32 + hf * 8; rxoff = 16; ri0 = hf * 8; rfd = 13.287712379549449f / 16.f; }
    else { rpt = (lane - 40) & 1; rbase = C_KR + rpt * 16; rxoff = 8; ri0 = 0; rfd = 13.287712379549449f / 8.f; }
    float rinvf[8];
#pragma unroll
    for (int j = 0; j < 8; ++j) rinvf[j] = __builtin_amdgcn_exp2f(-(float)(ri0 + j) * rfd);
    for (int r = gw; r < M_ALL; r += NGW) {
        bf16_t* q = WA + (size_t)r * WA_N + C_CQ + lane * 4;
        const u32x2 qv = *(const u32x2*)q;
        const float q0 = bflo(qv.x), q1 = bfhi(qv.x), q2 = bflo(qv.y), q3 = bfhi(qv.y);
        const float rq = rsqrtf(wave_sum(q0 * q0 + q1 * q1 + q2 * q2 + q3 * q3, lane) * (1.f / 256.f) + EPS);
        const f32x4 w4 = *(const f32x4*)(qw + lane * 4);
        u32x2 o; o.x = cvt_pk_bf16(q0 * rq * w4[0], q1 * rq * w4[1]); o.y = cvt_pk_bf16(q2 * rq * w4[2], q3 * rq * w4[3]);
        *(u32x2*)q = o;
        bf16_t* k = WA + (size_t)r * WA_N + C_CKV + lane * 2;
        const unsigned kv = *(const unsigned*)k;
        const float k0 = bflo(kv), k1 = bfhi(kv);
        const float rk = rsqrtf(wave_sum(k0 * k0 + k1 * k1, lane) * (1.f / 128.f) + EPS);
        *(unsigned*)k = cvt_pk_bf16(k0 * rk * kvw[lane * 2], k1 * rk * kvw[lane * 2 + 1]);
        if (r < M_LAT && ract) {
            const int t = r & 4095; const float pos = (float)(rpt ? (t & 63) : (t >> 6));
            bf16_t* x1p = WA + (size_t)r * WA_N + rbase;
            const u32x4 a = *(const u32x4*)x1p, b2 = *(const u32x4*)(x1p + rxoff);
            const float av[8] = {bflo(a.x), bfhi(a.x), bflo(a.y), bfhi(a.y), bflo(a.z), bfhi(a.z), bflo(a.w), bfhi(a.w)};
            const float bv[8] = {bflo(b2.x), bfhi(b2.x), bflo(b2.y), bfhi(b2.y), bflo(b2.z), bfhi(b2.z), bflo(b2.w), bfhi(b2.w)};
            float o1[8], o2[8];
#pragma unroll
            for (int j = 0; j < 8; ++j) { const float ang = pos * rinvf[j], cs = __cosf(ang), sn = __sinf(ang); o1[j] = av[j] * cs - bv[j] * sn; o2[j] = bv[j] * cs + av[j] * sn; }
            u32x4 w1, w2; w1.x = cvt_pk_bf16(o1[0], o1[1]); w1.y = cvt_pk_bf16(o1[2], o1[3]); w1.z = cvt_pk_bf16(o1[4], o1[5]); w1.w = cvt_pk_bf16(o1[6], o1[7]);
            w2.x = cvt_pk_bf16(o2[0], o2[1]); w2.y = cvt_pk_bf16(o2[2], o2[3]); w2.z = cvt_pk_bf16(o2[4], o2[5]); w2.w = cvt_pk_bf16(o2[6], o2[7]);
            *(u32x4*)x1p = w1; *(u32x4*)(x1p + rxoff) = w2;
        }
    }
}
DEV void final_phase(const int TID, KPP p) {
    const float* w = p->in[34];
    const int lane = TID & 63, wid = TID >> 6;
    const int gw = wid * gridDim.x + blockIdx.x, NGW = gridDim.x * NWAVES;
    for (int r = gw; r < M_LAT; r += NGW) {
        float* xr = p->out + (size_t)r * D;
        f32x4 x[4]; float ss = 0.f;
#pragma unroll
        for (int j = 0; j < 4; ++j) { x[j] = *(const f32x4*)(xr + j * 256 + lane * 4); ss += x[j][0] * x[j][0] + x[j][1] * x[j][1] + x[j][2] * x[j][2] + x[j][3] * x[j][3]; }
        const float rs = rsqrtf(wave_sum(ss, lane) * (1.f / D) + EPS);
#pragma unroll
        for (int j = 0; j < 4; ++j) { const int c = j * 256 + lane * 4; *(f32x4*)(xr + c) = x[j] * rs * *(const f32x4*)(w + c); }
    }
}

struct S5L { const float *lre, *lim, *ldt, *bre, *bim, *cre, *cim, *dsk; };
DEV void s5_lambar(const S5L& L, int gi, int pp, float& lre, float& lim, float& dt, float& lbr, float& lbi) {
    lre = L.lre[gi * 64 + pp]; lim = L.lim[gi * 64 + pp]; dt = __expf(L.ldt[gi]);
    const float er = __expf(lre * dt), ang = lim * dt;
    lbr = er * cosf(ang); lbi = er * sinf(ang);
}
DEV void s5_coef(float lre, float lim, float lbr, float lbi, float& cr, float& ci) {
    const float ar = lbr - 1.f, ai = lbi, den = 1.f / (lre * lre + lim * lim);
    cr = (ar * lre + ai * lim) * den; ci = (ai * lre - ar * lim) * den;
}
DEV int s5_row(int b, int dir, int k, int s) {
    const int pos = k * 64 + s;
    if (dir == 0) return pos < 256 ? M_LAT + b * 256 + pos : b * 4096 + (pos - 256);
    return pos < 256 ? M_LAT + b * 256 + (255 - pos) : b * 4096 + (4095 - (pos - 256));
}
DEV void s5_pre_phase(const int TID, KPP p, const S5L& L, unsigned char* lds, const int b0, const int nbk) {
    if ((int)blockIdx.x < b0) return;
    const int bj = (int)blockIdx.x - b0;
    bf16_t* KERN = (bf16_t*)(p->ws + WS_KERN); bf16_t* W3 = (bf16_t*)(p->ws + WS_WB);
    float2* Cs = (float2*)lds; float2* Bs = Cs + 1024; float2* PWs = Bs + 1024;
    for (int it = bj; it < 256; it += nbk) {
        const int dg = it >> 2, dq = it & 3;
        __syncthreads();
        for (int idx = TID; idx < 1024; idx += NTHREADS) {
            { const int c = idx >> 6, pp = idx & 63; Cs[idx] = make_float2(L.cre[(dg * 16 + c) * 64 + pp], L.cim[(dg * 16 + c) * 64 + pp]); }
            { const int pp = idx >> 4, c2 = idx & 15; float lre, lim, dt, lbr, lbi, cr, ci; s5_lambar(L, dg, pp, lre, lim, dt, lbr, lbi); s5_coef(lre, lim, lbr, lbi, cr, ci);
              const float br = L.bre[(size_t)(dg * 64 + pp) * 16 + c2], bi = L.bim[(size_t)(dg * 64 + pp) * 16 + c2];
              Bs[idx] = make_float2(cr * br - ci * bi, cr * bi + ci * br); }
            { const int dd = idx >> 6, pp = idx & 63; const float d = (float)(dq * 16 + dd);
              const float lre = L.lre[dg * 64 + pp], lim = L.lim[dg * 64 + pp], dt = __expf(L.ldt[dg]);
              const float er = __expf(d * lre * dt), ang = d * lim * dt; PWs[idx] = make_float2(er * cosf(ang), er * sinf(ang)); }
        }
        __syncthreads();
        {
            const int c2h = TID & 1, c = (TID >> 1) & 15, dd = TID >> 5;
            float sum[8];
#pragma unroll
            for (int j = 0; j < 8; ++j) sum[j] = 0.f;
#pragma unroll 4
            for (int pp = 0; pp < 64; ++pp) { const float2 cc = Cs[c * 64 + pp], pw = PWs[dd * 64 + pp];
                const float gr = cc.x * pw.x - cc.y * pw.y, gi = cc.x * pw.y + cc.y * pw.x;
                const f32x4* bp = (const f32x4*)(Bs + pp * 16 + c2h * 8);
#pragma unroll
                for (int q = 0; q < 4; ++q) { const f32x4 b2 = bp[q]; sum[2 * q] += gr * b2[0] - gi * b2[1]; sum[2 * q + 1] += gr * b2[2] - gi * b2[3]; } }
            u32x4 w; w.x = cvt_pk_bf16(sum[0], sum[1]); w.y = cvt_pk_bf16(sum[2], sum[3]); w.z = cvt_pk_bf16(sum[4], sum[5]); w.w = cvt_pk_bf16(sum[6], sum[7]);
            *(u32x4*)(KERN + (size_t)((dg * 64 + dq * 16 + dd) * 16 + c) * 16 + c2h * 8) = w;
        }
    }
    __syncthreads();
    for (int un = (TID >> 6) * nbk + bj; un < 64 * 16; un += nbk * NWAVES) {
        const int pp = TID & 63, c = un & 15, dg = un >> 4;
        float lre, lim, dt, lbr, lbi; s5_lambar(L, dg, pp, lre, lim, dt, lbr, lbi);
        const float cr = L.cre[(dg * 16 + c) * 64 + pp], ci = L.cim[(dg * 16 + c) * 64 + pp];
        float pr = lbr, pi = lbi;
        bf16_t* o = W3 + (size_t)(dg * 64 * 16 + c) * 128 + pp;
#pragma unroll 4
        for (int e = 0; e < 64; ++e) {
            o[(size_t)e * 16 * 128] = f2bf(cr * pr - ci * pi); o[(size_t)e * 16 * 128 + 64] = f2bf(-(cr * pi + ci * pr));
            const float nr = pr * lbr - pi * lbi, ni = pr * lbi + pi * lbr; pr = nr; pi = ni;
        }
    }
}
DEV void s5_local_phase(const int TID, KPP p, const S5L& L) {
    const bf16_t* WA = (const bf16_t*)(p->ws + WS_BIG + BIG_WA); float2* SB = (float2*)(p->ws + WS_S5);
    const int lane = TID & 63, wid = __builtin_amdgcn_readfirstlane(TID >> 6), fr = lane & 15, fq = lane >> 4, sh = fq >> 1, c0 = (fq & 1) * 8;
    const int gw = wid * gridDim.x + blockIdx.x, NGW = gridDim.x * NWAVES;
    for (int it = gw; it < 768; it += NGW) {
        const int nh = it % 3, mbp = (it / 3) & 3, dg = it / 12, dir = dg >> 5, g = dg & 31, pp = mbp * 16 + fr;
        float lre, lim, dt, lbr, lbi, cr, ci; s5_lambar(L, dg, pp, lre, lim, dt, lbr, lbi); s5_coef(lre, lim, lbr, lbi, cr, ci);
        float bbr[8], bbi[8];
        { const f32x4* brp = (const f32x4*)(L.bre + (size_t)(dg * 64 + pp) * 16 + c0); const f32x4* bip = (const f32x4*)(L.bim + (size_t)(dg * 64 + pp) * 16 + c0);
#pragma unroll
          for (int q = 0; q < 2; ++q) { const f32x4 r4 = brp[q], i4 = bip[q];
#pragma unroll
              for (int j = 0; j < 4; ++j) { bbr[q * 4 + j] = cr * r4[j] - ci * i4[j]; bbi[q * 4 + j] = cr * i4[j] + ci * r4[j]; } } }
        const float l2r = lbr * lbr - lbi * lbi, l2i = 2.f * lbr * lbi;
        float pr = sh ? 1.f : lbr, pi = sh ? 0.f : lbi;
        const int NB = (nh < 2) ? 6 : 5, nb0 = nh * 6;
        const bf16_t* ub[6]; int kcol[6];
#pragma unroll
        for (int nb = 0; nb < 6; ++nb) { int col = (nb0 + nb) * 16 + fr; if (col > 271) col = 271; const int b = col / 68, k = col % 68;
            kcol[nb] = (b * 2 + dir) * 68 + k; ub[nb] = WA + (size_t)s5_row(b, dir, k, 0) * WA_N + C_S5U + g * 16 + c0; }
        const ptrdiff_t sstep = (dir == 0) ? (ptrdiff_t)WA_N : -(ptrdiff_t)WA_N;
        f32x4 are[6], aim[6];
#pragma unroll
        for (int nb = 0; nb < 6; ++nb) { are[nb] = (f32x4){0.f, 0.f, 0.f, 0.f}; aim[nb] = (f32x4){0.f, 0.f, 0.f, 0.f}; }
        bf16x8 Bc[6], Bn[6], Bm[6];
#pragma unroll
        for (int nb = 0; nb < 6; ++nb) { Bc[nb] = *(const bf16x8*)(ub[nb] + (ptrdiff_t)(62 + sh) * sstep); Bn[nb] = *(const bf16x8*)(ub[nb] + (ptrdiff_t)(60 + sh) * sstep); Bm[nb] = Bn[nb]; }
#pragma unroll 1
        for (int kc = 31; kc >= 0; --kc) {
            if (kc > 1) {
#pragma unroll
                for (int nb = 0; nb < 6; ++nb) if (nb < NB) Bm[nb] = *(const bf16x8*)(ub[nb] + (ptrdiff_t)(2 * kc - 4 + sh) * sstep);
            }
            u32x4 wr_, wi_;
            wr_.x = cvt_pk_bf16(pr * bbr[0] - pi * bbi[0], pr * bbr[1] - pi * bbi[1]); wr_.y = cvt_pk_bf16(pr * bbr[2] - pi * bbi[2], pr * bbr[3] - pi * bbi[3]);
            wr_.z = cvt_pk_bf16(pr * bbr[4] - pi * bbi[4], pr * bbr[5] - pi * bbi[5]); wr_.w = cvt_pk_bf16(pr * bbr[6] - pi * bbi[6], pr * bbr[7] - pi * bbi[7]);
            wi_.x = cvt_pk_bf16(pr * bbi[0] + pi * bbr[0], pr * bbi[1] + pi * bbr[1]); wi_.y = cvt_pk_bf16(pr * bbi[2] + pi * bbr[2], pr * bbi[3] + pi * bbr[3]);
            wi_.z = cvt_pk_bf16(pr * bbi[4] + pi * bbr[4], pr * bbi[5] + pi * bbr[5]); wi_.w = cvt_pk_bf16(pr * bbi[6] + pi * bbr[6], pr * bbi[7] + pi * bbr[7]);
            const bf16x8 Ar = __builtin_bit_cast(bf16x8, wr_), Ai = __builtin_bit_cast(bf16x8, wi_);
#pragma unroll
            for (int nb = 0; nb < 6; ++nb) if (nb < NB) {
                are[nb] = __builtin_amdgcn_mfma_f32_16x16x32_bf16(Ar, Bc[nb], are[nb], 0, 0, 0);
                aim[nb] = __builtin_amdgcn_mfma_f32_16x16x32_bf16(Ai, Bc[nb], aim[nb], 0, 0, 0);
            }
#pragma unroll
            for (int nb = 0; nb < 6; ++nb) { Bc[nb] = Bn[nb]; Bn[nb] = Bm[nb]; }
            const float nr = pr * l2r - pi * l2i, ni = pr * l2i + pi * l2r; pr = nr; pi = ni;
        }
#pragma unroll
        for (int nb = 0; nb < 6; ++nb) if (nb < NB) {
            float2* o = SB + (size_t)kcol[nb] * 2048 + g * 64 + mbp * 16 + fq * 4;
#pragma unroll
            for (int j = 0; j < 4; ++j) o[j] = make_float2(are[nb][j], aim[nb][j]);
        }
    }
}
DEV void s5_carry_phase(const int TID, KPP p, const S5L& L) {
    const float2* __restrict__ SB = (const float2*)(p->ws + WS_S5); bf16_t* __restrict__ SBH = (bf16_t*)(p->ws + WS_SBH);
    if (TID >= 64) return;
    for (int idx = blockIdx.x * 64 + TID; idx < 4 * 2 * 32 * 64; idx += gridDim.x * 64) {
        const int pp = idx & 63, g = (idx >> 6) & 31, dir = (idx >> 11) & 1, b = idx >> 12;
        float lre, lim, dt, ar, ai; s5_lambar(L, dir * 32 + g, pp, lre, lim, dt, ar, ai);
#pragma unroll
        for (int q = 0; q < 6; ++q) { const float nr = ar * ar - ai * ai, ni = 2.f * ar * ai; ar = nr; ai = ni; }
        float sr = 0.f, si = 0.f;
        const float2* base = SB + (size_t)((b * 2 + dir) * 68) * 2048 + g * 64 + pp;
        bf16_t* ob = SBH + (size_t)((b * 2 + dir) * 68) * 4096 + g * 128 + pp;
#pragma unroll 17
        for (int k = 0; k < 68; ++k) { const float2 e = base[(size_t)k * 2048];
            ob[(size_t)k * 4096] = f2bf(sr); ob[(size_t)k * 4096 + 64] = f2bf(si);
            const float nr = ar * sr - ai * si + e.x, ni = ar * si + ai * sr + e.y; sr = nr; si = ni; }
    }
}
DEV float gelu_tanh(float x) { const float z = 0.7978845608028654f * (x + 0.044715f * x * x * x); const float t = 1.f - 2.f * __builtin_amdgcn_rcpf(1.f + __expf(2.f * z)); return 0.5f * x * (1.f + t); }
DEV void s5_out_phase(const int TID, KPP p, const S5L& L, bool lastl) {
    const bf16_t* WA = (const bf16_t*)(p->ws + WS_BIG + BIG_WA); const bf16_t* SBH = (const bf16_t*)(p->ws + WS_SBH); bf16_t* G5 = (bf16_t*)(p->ws + WS_G5);
    const bf16_t* KERN = (const bf16_t*)(p->ws + WS_KERN); const bf16_t* W3 = (const bf16_t*)(p->ws + WS_WB);
    const int lane = TID & 63, wid = __builtin_amdgcn_readfirstlane(TID >> 6), fr = lane & 15, fq = lane >> 4, sh = fq >> 1, c0 = (fq & 1) * 8;
    const int gw = wid * gridDim.x + blockIdx.x, NGW = gridDim.x * NWAVES;
    const int NG = lastl ? 4 : 5, ncols = lastl ? 256 : 272;
    for (int it = gw; it < 32 * 16 * NG; it += NGW) {
        const int ng = it % NG, tg = (it / NG) & 15, g = it / (NG * 16), t0 = tg * 4;
        int rowb[4]; const bf16_t* sbf[4]; const bf16_t* sbr[4];
#pragma unroll
        for (int nb = 0; nb < 4; ++nb) { int col = (ng * 4 + nb) * 16 + fr; if (col >= ncols) col = ncols - 1;
            const int b = lastl ? (col >> 6) : (col / 68), tc = lastl ? 4 + (col & 63) : (col % 68);
            rowb[nb] = (tc < 4) ? M_LAT + b * 256 + tc * 64 : b * 4096 + (tc - 4) * 64;
            const int kr = (tc < 4) ? 3 - tc : 71 - tc;
            sbf[nb] = SBH + (size_t)(((b * 2 + 0) * 68 + tc) * 32 + g) * 128 + fq * 8; sbr[nb] = SBH + (size_t)(((b * 2 + 1) * 68 + kr) * 32 + g) * 128 + fq * 8; }
        const int nvalid = (ncols - ng * 64 + 15) >> 4;
        f32x4 acc[4][4];
#pragma unroll
        for (int ti = 0; ti < 4; ++ti)
#pragma unroll
            for (int nb = 0; nb < 4; ++nb) acc[ti][nb] = (f32x4){0.f, 0.f, 0.f, 0.f};
        const bf16_t* kf = KERN + (size_t)(g * 64 * 16 + fr) * 16 + c0; const bf16_t* kr_ = KERN + (size_t)((32 + g) * 64 * 16 + fr) * 16 + c0;
#define S5O_LOAD(Bs_, Af_, Ar_, kc_) do { const int _tq = 2 * (kc_) + sh; \
            _Pragma("unroll") for (int nb = 0; nb < 4; ++nb) Bs_[nb] = *(const bf16x8*)(WA + (size_t)(rowb[nb] + _tq) * WA_N + C_S5U + g * 16 + c0); \
            _Pragma("unroll") for (int ti = 0; ti < 4; ++ti) { const int _df = t0 + ti - _tq, _dr = _tq - t0 - ti; \
                u32x4 _a = *(const u32x4*)(kf + (size_t)(_df < 0 ? 0 : _df) * 256); if (_df < 0) _a = (u32x4){0u, 0u, 0u, 0u}; Af_[ti] = __builtin_bit_cast(bf16x8, _a); \
                u32x4 _b = *(const u32x4*)(kr_ + (size_t)(_dr < 0 ? 0 : _dr) * 256); if (_dr < 0) _b = (u32x4){0u, 0u, 0u, 0u}; Ar_[ti] = __builtin_bit_cast(bf16x8, _b); } } while (0)
#define S5O_MMA(Bs_, Af_, Ar_, kc_) do { \
            _Pragma("unroll") for (int ti = 0; ti < 4; ++ti) { const int t = t0 + ti; \
                if (t >= 2 * (kc_)) { _Pragma("unroll") for (int nb = 0; nb < 4; ++nb) if (nb < nvalid) acc[ti][nb] = __builtin_amdgcn_mfma_f32_16x16x32_bf16(Af_[ti], Bs_[nb], acc[ti][nb], 0, 0, 0); } \
                if (2 * (kc_) + 1 >= t) { _Pragma("unroll") for (int nb = 0; nb < 4; ++nb) if (nb < nvalid) acc[ti][nb] = __builtin_amdgcn_mfma_f32_16x16x32_bf16(Ar_[ti], Bs_[nb], acc[ti][nb], 0, 0, 0); } } } while (0)
        {
            bf16x8 B0[4], F0[4], R0[4], B1[4], F1[4], R1[4];
            S5O_LOAD(B0, F0, R0, 0);
#pragma unroll 1
            for (int kc = 0; kc < 32; kc += 2) {
                S5O_LOAD(B1, F1, R1, kc + 1);
                S5O_MMA(B0, F0, R0, kc);
                if (kc + 2 < 32) S5O_LOAD(B0, F0, R0, kc + 2);
                S5O_MMA(B1, F1, R1, kc + 1);
            }
        }
#undef S5O_LOAD
#undef S5O_MMA
#pragma unroll 1
        for (int dir = 0; dir < 2; ++dir)
#pragma unroll
            for (int kc2 = 0; kc2 < 4; ++kc2) {
                bf16x8 B[4];
#pragma unroll
                for (int nb = 0; nb < 4; ++nb) B[nb] = *(const bf16x8*)((dir ? sbr[nb] : sbf[nb]) + kc2 * 32);
#pragma unroll
                for (int ti = 0; ti < 4; ++ti) { const int t = t0 + ti, e = dir ? 63 - t : t;
                    const bf16x8 A = *(const bf16x8*)(W3 + (size_t)(((dir * 32 + g) * 64 + e) * 16 + fr) * 128 + kc2 * 32 + fq * 8);
#pragma unroll
                    for (int nb = 0; nb < 4; ++nb) if (nb < nvalid) acc[ti][nb] = __builtin_amdgcn_mfma_f32_16x16x32_bf16(A, B[nb], acc[ti][nb], 0, 0, 0); }
            }
        const f32x4 dsk = *(const f32x4*)(L.dsk + g * 16 + fq * 4);
#pragma unroll
        for (int nb = 0; nb < 4; ++nb) if (nb < nvalid)
#pragma unroll
            for (int ti = 0; ti < 4; ++ti) {
                const size_t row = (size_t)(rowb[nb] + t0 + ti);
                const u32x2 uw = *(const u32x2*)(WA + row * WA_N + C_S5U + g * 16 + fq * 4);
                const f32x4 a = acc[ti][nb];
                const float y0 = gelu_tanh(a[0] + dsk[0] * bflo(uw.x)), y1 = gelu_tanh(a[1] + dsk[1] * bfhi(uw.x)), y2 = gelu_tanh(a[2] + dsk[2] * bflo(uw.y)), y3 = gelu_tanh(a[3] + dsk[3] * bfhi(uw.y));
                u32x2 w; w.x = cvt_pk_bf16(y0, y1); w.y = cvt_pk_bf16(y2, y3);
                *(u32x2*)(G5 + row * 512 + g * 16 + fq * 4) = w;
            }
    }
}

struct AttnP { const bf16_t* WA; const bf16_t* MLAQ; const bf16_t* MLAKV; bf16_t* Y; const float* rpb; const float* sink; };
typedef float f32x16 __attribute__((ext_vector_type(16)));
DEV float half_max(float x) { auto q = __builtin_amdgcn_permlane32_swap(__float_as_uint(x), __float_as_uint(x), false, false); return fmaxf(__uint_as_float(q[0]), __uint_as_float(q[1])); }
DEV float half_sum(float x) { auto q = __builtin_amdgcn_permlane32_swap(__float_as_uint(x), __float_as_uint(x), false, false); return __uint_as_float(q[0]) + __uint_as_float(q[1]); }
template <int TYPE  >
DEV void attn_item(const int TID, unsigned char* lds, const AttnP& P, int b, int h, int qt) {
    constexpr int DQ = (TYPE == 2) ? 96 : 64, NC = DQ / 16, KPI = DQ + 8, VPI = 68, BUFSZ = 22016;
    float* rp = (float*)(lds + 2 * BUFSZ);
    const int tid = TID, lane = tid & 63, wid = __builtin_amdgcn_readfirstlane(tid >> 6), l31 = lane & 31, hi = lane >> 5;
    const bool cq = (qt == 16);
    const int qrow0 = cq ? M_LAT + b * 256 : b * 4096 + qt * 256;
    const bf16_t *Qp, *K0p, *Vp; int qpitch, kpitch;
    if (TYPE == 0) { Qp = P.WA + C_NAQ + h * 64; qpitch = WA_N; K0p = P.WA + C_NAK + h * 64; Vp = P.WA + C_NAV + h * 64; kpitch = WA_N; }
    else if (TYPE == 1) { Qp = P.WA + C_SWQ + h * 64; qpitch = WA_N; K0p = P.WA + C_SWK + (h >> 2) * 64; Vp = P.WA + C_SWV + (h >> 2) * 64; kpitch = WA_N; }
    else { Qp = P.MLAQ + h * 96; qpitch = 768; K0p = P.MLAKV + h * 128; Vp = P.MLAKV + h * 128 + 64; kpitch = 1024; }
    const bf16_t* K1p = P.WA + C_KR;
    int lo = 0, hi_t = 0, wlo = 0, whi = 0;
    const int qw = qt * 256 + wid * 32;
    if (!cq) {
        if (TYPE == 0) { lo = clampi(qt * 4 - 4, 0, 56); hi_t = clampi(qt * 4 + 3 - 4, 0, 56) + 8; wlo = clampi((qw >> 6) - 4, 0, 56); whi = wlo + 8; }
        else if (TYPE == 1) { lo = qt * 4 - 2; if (lo < 0) lo = 0; hi_t = qt * 4 + 6; if (hi_t > 64) hi_t = 64;
            wlo = (qw - 128 < 0 ? 0 : qw - 128) >> 6; whi = ((qw + 31 + 128) >> 6) + 1; if (whi > 64) whi = 64; }
        else { lo = 0; hi_t = 64; wlo = 0; whi = 64; }
    }
    const int nloc = hi_t - lo, nt = nloc + 4;
    const float sc = ((TYPE == 2) ? 0.10206207261596575f : 0.125f) * LOG2E;
    __syncthreads();
    if (TYPE == 0 && !cq && tid < 465) rp[tid] = P.rpb[h * 465 + tid] * LOG2E;
    const int qrow = qrow0 + wid * 32 + l31;
    bf16x8 Qf[NC];
#pragma unroll
    for (int c = 0; c < NC; ++c) {
        const u32x4 w = *(const u32x4*)(Qp + (size_t)qrow * qpitch + c * 16 + hi * 8);
        float v[8] = {bflo(w.x), bfhi(w.x), bflo(w.y), bfhi(w.y), bflo(w.z), bfhi(w.z), bflo(w.w), bfhi(w.w)};
        if (TYPE == 2 && c >= 4 && !cq) {
            const int t = qrow & 4095; const float pos = (float)((c == 5) ? (t & 63) : (t >> 6));
#pragma unroll
            for (int j = 0; j < 8; ++j) {
                const float other = shflx(v[j], lane, 32);
                const float ang = pos * __builtin_amdgcn_exp2f(-(float)j * (13.287712379549449f / 8.f)), cs = __cosf(ang), sn = __sinf(ang);
                v[j] = hi ? (v[j] * cs + other * sn) : (v[j] * cs - other * sn);
            }
        }
        u32x4 o; o.x = cvt_pk_bf16(v[0] * sc, v[1] * sc); o.y = cvt_pk_bf16(v[2] * sc, v[3] * sc); o.z = cvt_pk_bf16(v[4] * sc, v[5] * sc); o.w = cvt_pk_bf16(v[6] * sc, v[7] * sc);
        Qf[c] = __builtin_bit_cast(bf16x8, o);
    }
    f32x16 O[2]; float mrun, lrun;
#pragma unroll
    for (int db = 0; db < 2; ++db)
#pragma unroll
        for (int r = 0; r < 16; ++r) O[db][r] = 0.f;
    if (TYPE == 1) { mrun = P.sink[h] * LOG2E; lrun = (hi == 0) ? 1.f : 0.f; } else { mrun = -1e30f; lrun = 0.f; }
    const int qtok = qw + l31, qr = qtok >> 6, qc = qtok & 63, r0 = clampi(qr - 4, 0, 56), c0 = clampi(qc - 8, 0, 48);
    u32x4 kr0, kr1, vr; kr1 = (u32x4){0u, 0u, 0u, 0u};
    auto tile_row0 = [&](int i) { return (i < nloc) ? b * 4096 + (lo + i) * 64 : M_LAT + b * 256 + (i - nloc) * 64; };
#define ATT_PREFETCH(i) do { const int _r0 = tile_row0(i); \
        kr0 = *(const u32x4*)(K0p + (size_t)(_r0 + (tid >> 3)) * kpitch + (tid & 7) * 8); \
        if (TYPE == 2 && tid < 256) kr1 = *(const u32x4*)(K1p + (size_t)(_r0 + (tid >> 2)) * WA_N + (tid & 3) * 8); \
        vr = *(const u32x4*)(Vp + (size_t)(_r0 + (tid >> 3)) * kpitch + (tid & 7) * 8); } while (0)
#define ATT_WRITE(bufi) do { bf16_t* _Ks = (bf16_t*)(lds + (bufi) * BUFSZ); bf16_t* _Vt = (bf16_t*)(lds + (bufi) * BUFSZ + 64 * KPI * 2); \
        *(u32x4*)(_Ks + (tid >> 3) * KPI + (tid & 7) * 8) = kr0; \
        if (TYPE == 2 && tid < 256) *(u32x4*)(_Ks + (tid >> 2) * KPI + 64 + (tid & 3) * 8) = kr1; \
        bf16_t* vp = _Vt + ((tid & 7) * 8) * VPI + ((tid >> 3) ^ ((tid & 7) * 8));   \
        vp[0 * VPI] = (bf16_t)(vr.x & 0xffffu); vp[1 * VPI] = (bf16_t)(vr.x >> 16); vp[2 * VPI] = (bf16_t)(vr.y & 0xffffu); vp[3 * VPI] = (bf16_t)(vr.y >> 16); \
        vp[4 * VPI] = (bf16_t)(vr.z & 0xffffu); vp[5 * VPI] = (bf16_t)(vr.z >> 16); vp[6 * VPI] = (bf16_t)(vr.w & 0xffffu); vp[7 * VPI] = (bf16_t)(vr.w >> 16); } while (0)
    ATT_PREFETCH(0); ATT_WRITE(0); ATT_PREFETCH(1);
    __syncthreads();
    for (int i = 0; i < nt; ++i) {
        const bf16_t* Ks = (const bf16_t*)(lds + (i & 1) * BUFSZ); const bf16_t* Vt = (const bf16_t*)(lds + (i & 1) * BUFSZ + 64 * KPI * 2);
        const bool local = i < nloc; const int kt = lo + i;
        if (!(local && (kt < wlo || kt >= whi))) {
        f32x16 S[2];
#pragma unroll
        for (int kb = 0; kb < 2; ++kb) {
            bf16x8 Kf[NC];
#pragma unroll
            for (int c = 0; c < NC; ++c) Kf[c] = *(const bf16x8*)(Ks + (kb * 32 + l31) * KPI + c * 16 + hi * 8);
            __builtin_amdgcn_sched_barrier(0);
            f32x16 acc;
#pragma unroll
            for (int r = 0; r < 16; ++r) acc[r] = 0.f;
#pragma unroll
            for (int c = 0; c < NC; ++c) acc = __builtin_amdgcn_mfma_f32_32x32x16_bf16(Kf[c], Qf[c], acc, 0, 0, 0);
            S[kb] = acc;
            __builtin_amdgcn_sched_barrier(0);
        }
        u32x2 Vf[4][2];
#pragma unroll
        for (int ck = 0; ck < 4; ++ck) { const bf16_t* vp = Vt + l31 * VPI; const int sw = (l31 >> 3) * 8; Vf[ck][0] = *(const u32x2*)(vp + ((ck * 16 + hi * 4) ^ sw)); Vf[ck][1] = *(const u32x2*)(vp + ((ck * 16 + 8 + hi * 4) ^ sw)); }
        __builtin_amdgcn_sched_barrier(0);
        float mx = -1e30f;
#pragma unroll
        for (int kb = 0; kb < 2; ++kb)
#pragma unroll
            for (int r = 0; r < 16; ++r) {
                const int kk = kb * 32 + (r & 3) + 8 * (r >> 2) + 4 * hi;
                float t = S[kb][r];
                if (TYPE != 2 && local) {
                    if (TYPE == 0) { const bool ok = ((unsigned)(kt - r0) < 8u) && ((unsigned)(kk - c0) < 16u);
                        if (ok) t += rp[(kt - qr + 7) * 31 + (kk - qc + 15)]; else t = -1e30f; }
                    else if (TYPE == 1) { int dlt = qtok - (kt * 64 + kk); if (dlt < 0) dlt = -dlt; if (dlt > 128) t = -1e30f; }
                    S[kb][r] = t;
                }
                mx = fmaxf(mx, t);
            }
        mx = half_max(mx);
        const float mn = fmaxf(mrun, mx), alpha = __builtin_amdgcn_exp2f(mrun - mn); mrun = mn;
        float ps = 0.f;
#pragma unroll
        for (int kb = 0; kb < 2; ++kb)
#pragma unroll
            for (int r = 0; r < 16; ++r) { const float t = S[kb][r];
                float pv = __builtin_amdgcn_exp2f(t - mn); if (TYPE != 2) pv = (t > -1e29f) ? pv : 0.f;
                S[kb][r] = pv; ps += pv; }
        lrun = lrun * alpha + ps;
        if (__builtin_amdgcn_ballot_w64(alpha != 1.f)) {
#pragma unroll
            for (int db = 0; db < 2; ++db) O[db] *= alpha;
        }
        bf16x8 Pf[4];
#pragma unroll
        for (int kb = 0; kb < 2; ++kb)
#pragma unroll
            for (int m = 0; m < 2; ++m) { u32x4 w; w.x = cvt_pk_bf16(S[kb][8 * m], S[kb][8 * m + 1]); w.y = cvt_pk_bf16(S[kb][8 * m + 2], S[kb][8 * m + 3]);
                w.z = cvt_pk_bf16(S[kb][8 * m + 4], S[kb][8 * m + 5]); w.w = cvt_pk_bf16(S[kb][8 * m + 6], S[kb][8 * m + 7]); Pf[2 * kb + m] = __builtin_bit_cast(bf16x8, w); }
        u32x2 Vg[4][2];
#pragma unroll
        for (int ck = 0; ck < 4; ++ck) { const bf16_t* vp = Vt + (32 + l31) * VPI; const int sw = (4 + (l31 >> 3)) * 8; Vg[ck][0] = *(const u32x2*)(vp + ((ck * 16 + hi * 4) ^ sw)); Vg[ck][1] = *(const u32x2*)(vp + ((ck * 16 + 8 + hi * 4) ^ sw)); }
#pragma unroll
        for (int ck = 0; ck < 4; ++ck) { u32x4 w; w.x = Vf[ck][0].x; w.y = Vf[ck][0].y; w.z = Vf[ck][1].x; w.w = Vf[ck][1].y;
            O[0] = __builtin_amdgcn_mfma_f32_32x32x16_bf16(__builtin_bit_cast(bf16x8, w), Pf[ck], O[0], 0, 0, 0); }
#pragma unroll
        for (int ck = 0; ck < 4; ++ck) { u32x4 w; w.x = Vg[ck][0].x; w.y = Vg[ck][0].y; w.z = Vg[ck][1].x; w.w = Vg[ck][1].y;
            O[1] = __builtin_amdgcn_mfma_f32_32x32x16_bf16(__builtin_bit_cast(bf16x8, w), Pf[ck], O[1], 0, 0, 0); }
        }
        if (i + 1 < nt) ATT_WRITE((i + 1) & 1);
        __syncthreads();
        if (i + 2 < nt) ATT_PREFETCH(i + 2);
    }
#undef ATT_PREFETCH
#undef ATT_WRITE
    const int ycol = (TYPE == 0 ? 0 : (TYPE == 1 ? 512 : 1536)) + h * 64;
    const float inv = __builtin_amdgcn_rcpf(half_sum(lrun));
    bf16_t* yp = P.Y + (size_t)qrow * 2048 + ycol + hi * 4;
#pragma unroll
    for (int db = 0; db < 2; ++db)
#pragma unroll
        for (int rg = 0; rg < 4; ++rg) { u32x2 w; w.x = cvt_pk_bf16(O[db][4 * rg] * inv, O[db][4 * rg + 1] * inv); w.y = cvt_pk_bf16(O[db][4 * rg + 2] * inv, O[db][4 * rg + 3] * inv);
            *(u32x2*)(yp + db * 32 + rg * 8) = w; }
}
DEV void attn_phase(const int TID, unsigned char* lds, const AttnP& P, int nqt  ) {
    const int total = 3 * 512 + (nqt == 17 ? 96 : 0);
    const int vb = (gridDim.x % 8 == 0) ? (int)((blockIdx.x & 7) * (gridDim.x >> 3) + (blockIdx.x >> 3)) : (int)blockIdx.x;
    for (int it = vb; it < total; it += gridDim.x) {
        int type, b, h, qt;
        if (it < 1536) { type = 2 - (it >> 9); const int r = it & 511; qt = r & 15; h = (r >> 4) & 7; b = r >> 7; }
        else { const int r = it - 1536; type = 2 - r / 32; qt = 16; h = r & 7; b = (r >> 3) & 3; }
        if (type == 2) attn_item<2>(TID, lds, P, b, h, qt); else if (type == 1) attn_item<1>(TID, lds, P, b, h, qt); else attn_item<0>(TID, lds, P, b, h, qt);
    }
    __syncthreads();
}

DEV void mini_tile(const int TID, unsigned char* lds, const bf16_t* Ap, int lda, const bf16_t* Bp, int K, float (&v)[8], const int bstride = 16) {
    const int lane = TID & 63, wid = __builtin_amdgcn_readfirstlane(TID >> 6), fr = lane & 15, fq = lane >> 4;
    const int ksl = K >> 3, k0 = wid * ksl;
    f32x4 acc[4][4];
#pragma unroll
    for (int mb = 0; mb < 4; ++mb)
#pragma unroll
        for (int nb = 0; nb < 4; ++nb) acc[mb][nb] = (f32x4){0.f, 0.f, 0.f, 0.f};
    const bf16_t* ap = Ap + (size_t)fr * lda + k0 + fq * 8; const bf16_t* bp = Bp + (size_t)fr * K + k0 + fq * 8;
#pragma unroll 2
    for (int kk = 0; kk < ksl; kk += 32) {
        bf16x8 a[4], b[4];
#pragma unroll
        for (int i = 0; i < 4; ++i) { a[i] = *(const bf16x8*)(ap + (size_t)(i * 16) * lda + kk); b[i] = *(const bf16x8*)(bp + (size_t)(i * bstride) * K + kk); }
#pragma unroll
        for (int mb = 0; mb < 4; ++mb)
#pragma unroll
            for (int nb = 0; nb < 4; ++nb) acc[mb][nb] = __builtin_amdgcn_mfma_f32_16x16x32_bf16(a[mb], b[nb], acc[mb][nb], 0, 0, 0);
    }
    float* red = (float*)lds;
    __syncthreads();
#pragma unroll
    for (int mb = 0; mb < 4; ++mb)
#pragma unroll
        for (int nb = 0; nb < 4; ++nb)
#pragma unroll
            for (int j = 0; j < 4; ++j) red[wid * 4096 + (mb * 16 + fq * 4 + j) * 64 + nb * 16 + fr] = acc[mb][nb][j];
    __syncthreads();
    const float* rr = red + (TID >> 3) * 64 + (TID & 7) * 8;
    f32x4 s0 = *(const f32x4*)rr, s1 = *(const f32x4*)(rr + 4);
#pragma unroll
    for (int w = 1; w < 8; ++w) { s0 += *(const f32x4*)(rr + w * 4096); s1 += *(const f32x4*)(rr + w * 4096 + 4); }
    v[0] = s0[0]; v[1] = s0[1]; v[2] = s0[2]; v[3] = s0[3]; v[4] = s1[0]; v[5] = s1[1]; v[6] = s1[2]; v[7] = s1[3];
}
DEV void mini_resid(const int TID, unsigned char* lds, const bf16_t* A, int lda, const bf16_t* Bt, int K, const float* inc, float* outc, const float* gate, float s) {
    for (int it = blockIdx.x; it < 256; it += gridDim.x) {
        const int r0 = (it >> 4) * 64, c0 = (it & 15) * 64; float v[8];
        mini_tile(TID, lds, A + (size_t)(M_LAT + r0) * lda, lda, Bt + (size_t)c0 * K, K, v);
        const int row = r0 + (TID >> 3), col = c0 + (TID & 7) * 8; const size_t off = (size_t)row * D + col;
#pragma unroll
        for (int q = 0; q < 2; ++q) { const f32x4 g4 = *(const f32x4*)(gate + col + q * 4) * s, b4 = *(const f32x4*)(inc + off + q * 4);
            f32x4 a4; a4[0] = v[q * 4]; a4[1] = v[q * 4 + 1]; a4[2] = v[q * 4 + 2]; a4[3] = v[q * 4 + 3];
            *(f32x4*)(outc + off + q * 4) = b4 + g4 * a4; }
    }
    __syncthreads();
}
DEV void mini_pgemm(const int TID, unsigned char* lds, const bf16_t* Yb, const bf16_t* Wbr, bf16_t* PBo) {
    for (int it = blockIdx.x; it < 1024; it += gridDim.x) {
        const int r0 = (it >> 6) * 64, c0 = (it & 63) * 64; float v[8];
        mini_tile(TID, lds, Yb + (size_t)(M_LAT + r0) * 2048 + (c0 >> 10) * 512, 2048, Wbr + (size_t)c0 * 512, 512, v);
        const int row = M_LAT + r0 + (TID >> 3), col = c0 + (TID & 7) * 8;
        u32x4 w; w.x = cvt_pk_bf16(v[0], v[1]); w.y = cvt_pk_bf16(v[2], v[3]); w.z = cvt_pk_bf16(v[4], v[5]); w.w = cvt_pk_bf16(v[6], v[7]);
        *(u32x4*)(PBo + (size_t)row * 4096 + col) = w;
    }
    __syncthreads();
}
DEV void mini_merge(const int TID, unsigned char* lds, const bf16_t* XNb, const bf16_t* Wg, const bf16_t* PBi, bf16_t* MBo) {
    for (int it = blockIdx.x; it < 256; it += gridDim.x) {
        const int r0 = (it >> 4) * 64, c0 = (it & 15) * 64;
        const int row = M_LAT + r0 + (TID >> 3), col = c0 + (TID & 7) * 8;
        float R[8];
#pragma unroll
        for (int j = 0; j < 8; ++j) R[j] = 0.f;
#pragma unroll 1
        for (int n = 0; n < 4; ++n) {
            const int bro = (c0 >> 6) * 256 + (n >> 1) * 128 + (n & 1) * 16; float v[8];
            mini_tile(TID, lds, XNb + (size_t)(M_LAT + r0) * D, D, Wg + (size_t)bro * D, D, v, 32);
            const u32x4 pw = *(const u32x4*)(PBi + (size_t)row * 4096 + n * 1024 + col);
            R[0] += bflo(pw.x) * sigmoidf_(v[0]); R[1] += bfhi(pw.x) * sigmoidf_(v[1]); R[2] += bflo(pw.y) * sigmoidf_(v[2]); R[3] += bfhi(pw.y) * sigmoidf_(v[3]);
            R[4] += bflo(pw.z) * sigmoidf_(v[4]); R[5] += bfhi(pw.z) * sigmoidf_(v[5]); R[6] += bflo(pw.w) * sigmoidf_(v[6]); R[7] += bfhi(pw.w) * sigmoidf_(v[7]);
        }
        u32x4 w; w.x = cvt_pk_bf16(R[0], R[1]); w.y = cvt_pk_bf16(R[2], R[3]); w.z = cvt_pk_bf16(R[4], R[5]); w.w = cvt_pk_bf16(R[6], R[7]);
        *(u32x4*)(MBo + (size_t)row * D + col) = w;
    }
    __syncthreads();
}

#define LAS __attribute__((address_space(3)))
#define XB_TMO      128
#define XB_XCNT(j)  (256  + 64 * (j))
#define XB_XSUB(j)  (1280 + 64 * (j))
#define XB_XGEN(j)  (2304 + 64 * (j))
#define XB_TOP      3328
#define XB_TOPGEN   3392
#define XCD_BAR_WORDS 3456
#define XB_SPIN_CAP (1u << 18)

__device__ __forceinline__ unsigned xb_ld(unsigned* p)              { return __hip_atomic_load(p, __ATOMIC_RELAXED, __HIP_MEMORY_SCOPE_AGENT); }
__device__ __forceinline__ unsigned xb_add(unsigned* p, unsigned v) { return __hip_atomic_fetch_add(p, v, __ATOMIC_RELAXED, __HIP_MEMORY_SCOPE_AGENT); }
__device__ __forceinline__ unsigned xb_xcc_id() { return (unsigned)__builtin_amdgcn_s_getreg((3 << 11) | 20) & 0xFu; }
#define XB_SPIN(cond, bar) do { unsigned _sp = 0; while (cond) { __builtin_amdgcn_s_sleep(1); \
    if ((++_sp & 255u) == 0u) { if (xb_ld(&(bar)[XB_TMO])) break; if (_sp > XB_SPIN_CAP) { atomicAdd(&(bar)[XB_TMO], 1u); break; } } } } while (0)

struct XcdBarrier {
    unsigned* bar; unsigned x;
    volatile LAS unsigned* st;
};

__device__ __forceinline__ XcdBarrier xcd_barrier_post(unsigned* bar, volatile LAS unsigned* st) {
    XcdBarrier b; b.bar = bar; b.x = xb_xcc_id(); b.st = st;
    if (threadIdx.x == 0) (void)xb_add(&bar[XB_XCNT(b.x)], 1u);
    return b;
}
__device__ __forceinline__ void xcd_barrier_complete(unsigned* bar, unsigned x, unsigned& nloc, unsigned& nx) {
    const unsigned G = gridDim.x * gridDim.y * gridDim.z;
    unsigned sum, cnt, mine, sp = 0u;
    for (;;) {
        sum = 0u; cnt = 0u; mine = 0u;
#pragma unroll
        for (unsigned j = 0; j < 16; ++j) { const unsigned c = xb_ld(&bar[XB_XCNT(j)]); sum += c; cnt += (c > 0u) ? 1u : 0u; mine = (j == x) ? c : mine; }
        if (sum == G) break;
        __builtin_amdgcn_s_sleep(1);
        if ((++sp & 255u) == 0u) { if (xb_ld(&bar[XB_TMO])) break; if (sp > XB_SPIN_CAP) { atomicAdd(&bar[XB_TMO], 1u); break; } }
    }
    nloc = mine > 0u ? mine : 1u; nx = cnt > 0u ? cnt : 1u;
}

__device__ __forceinline__ void xcd_barrier(const XcdBarrier& b) {
    asm volatile("s_waitcnt vmcnt(0)" ::: "memory");
    __syncthreads();
    if (threadIdx.x == 0) {
        unsigned* bar = b.bar;
        __builtin_amdgcn_s_waitcnt(0);
        unsigned nloc = b.st[0], nx = b.st[1];
        if (nloc == 0u) { xcd_barrier_complete(bar, b.x, nloc, nx); b.st[0] = nloc; b.st[1] = nx; }
        const unsigned old = xb_add(&bar[XB_XSUB(b.x)], 1u);
        const unsigned gen = old / nloc;
        if (old + 1u == (gen + 1u) * nloc) {
            __builtin_amdgcn_fence(__ATOMIC_RELEASE, "agent");
            asm volatile("s_waitcnt vmcnt(0)" ::: "memory");
            const unsigned og = xb_add(&bar[XB_TOP], 1u);
            const unsigned tg = og / nx;
            if (og + 1u == (tg + 1u) * nx) xb_add(&bar[XB_TOPGEN], 1u);
            else XB_SPIN(xb_ld(&bar[XB_TOPGEN]) == tg, bar);
            __builtin_amdgcn_fence(__ATOMIC_ACQUIRE, "agent");
            xb_add(&bar[XB_XGEN(b.x)], 1u);
            asm volatile("s_waitcnt vmcnt(0)" ::: "memory");
        } else {
            XB_SPIN(xb_ld(&bar[XB_XGEN(b.x)]) == gen, bar);
            __builtin_amdgcn_fence(__ATOMIC_ACQUIRE, "agent");
            asm volatile("s_waitcnt vmcnt(0)" ::: "memory");
        }
    }
    __syncthreads();
}

#ifndef PHMASK
#define PHMASK 0xffffffffu
#endif
constexpr int PER_LAYER = 15;
constexpr int N_PHASES = 1 + 2 * PER_LAYER + 1;
__global__ void __launch_bounds__(NTHREADS, 2) fwd_kernel(KP pbyval) {
    extern __shared__ __attribute__((aligned(16))) unsigned char lds[];
    cg::grid_group grid = cg::this_grid();
    KPP p = (KPP)__builtin_amdgcn_kernarg_segment_ptr();
    const int ph_lo = p->ph_lo, ph_hi = p->ph_hi;
    const int wid_s = __builtin_amdgcn_readfirstlane((int)(threadIdx.x >> 6));
    volatile LAS unsigned* bst = (volatile LAS unsigned*)((LAS unsigned char*)lds + (LDS_BYTES - 64));
    if (threadIdx.x < 2) bst[threadIdx.x] = 0u;
    __syncthreads();
    const XcdBarrier xbar = xcd_barrier_post((unsigned*)(p->ws + WS_CTL), bst);
#pragma unroll 1
    for (int ph = ph_lo; ph < ph_hi; ++ph) {
        asm volatile("" : "+s"(p));
        unsigned allm = ~0u; asm volatile("" : "+s"(allm));
        int TID = (wid_s << 6) | (int)__builtin_amdgcn_mbcnt_hi(allm, __builtin_amdgcn_mbcnt_lo(allm, 0u)); asm volatile("" : "+v"(TID));
        int kind, l;
        if (ph < 1) { kind = 0; l = 0; } else if (ph == N_PHASES - 1) { kind = 18; l = 0; } else { l = (ph - 1) / PER_LAYER; kind = 2 + (ph - 1) % PER_LAYER; if (kind >= 9) kind += 1; }
        PG8_LAS unsigned char* ldsl = (PG8_LAS unsigned char*)lds;
        const int G = gridDim.x, cb = blockIdx.x;
        const bool last = (l == 1);
        const int Mpost = last ? M_LAT : M_ALL;
#define MOD ((float*)(p->ws + WS_MOD))
#define HC ((float*)(p->ws + WS_HC))
#define XN ((bf16_t*)(p->ws + WS_XN))
#define Y ((bf16_t*)(p->ws + WS_Y))
#define G5 ((bf16_t*)(p->ws + WS_G5))
#define WA ((bf16_t*)(p->ws + WS_BIG + BIG_WA))
#define MLAQ ((bf16_t*)(p->ws + WS_BIG + BIG_MLAQ))
#define MLAKV ((bf16_t*)(p->ws + WS_BIG + BIG_MLAKV))
#define ACT ((bf16_t*)(p->ws + WS_BIG))
#define PB ((bf16_t*)(p->ws + WS_BIG + BIG_P))
#define MB ((bf16_t*)(p->ws + WS_BIG + BIG_MB))
#define wb (p->ws + WS_WB)
#define modl (MOD + (size_t)l * 5 * 9 * 1024)
#define KIND(k) (((PHMASK >> (k)) & 1u) && kind == (k))
        if (KIND(0)) { modp_phase(TID, p, lds); wprep_phase(TID, p, lds, 0, 0); }
        else if (KIND(2)) { const float* hlat = (l == 0) ? p->in[0] : p->out; const float* hctx = (l == 0) ? p->in[2] : HC;
            norm_phase(TID, p, hlat, hctx, p->in[6] + l * D, modl, 0, M_ALL); if (l == 1) wprep_phase(TID, p, lds, 1, 0); }
        else if (KIND(3)) { pg8::Gemm g{XN, D, (const bf16_t*)(wb + WB_GU), M_ALL, 5632, D, 0, 0}; pg8::StaticOrder S; S.init(M_ALL, 5632, G, cb); EpiSwiglu E{ACT};
            pg8::gemm_phase<EpiSwiglu, pg8::StaticOrder, true, true>(TID, ldsl, g, S, E); }
        else if (KIND(4)) { const float* hlat = (l == 0) ? p->in[0] : p->out; const float* hctx = (l == 0) ? p->in[2] : HC;
            pg8::Gemm g{ACT, DFF, (const bf16_t*)(wb + WB_DN), M_LAT, D, DFF, 0, 0}; pg8::StaticOrder S; S.init(M_LAT, D, G, cb);
            EpiResid E{hlat, hctx, p->out, HC, modl + 2 * 1024, 0.5f};
            pg8::gemm_phase<EpiResid, pg8::StaticOrder, true, true>(TID, ldsl, g, S, E);
            mini_resid(TID, lds, ACT, DFF, (const bf16_t*)(wb + WB_DN), DFF, hctx, HC, modl + (size_t)(4 * 9 + 2) * 1024, 0.5f); }
        else if (KIND(5)) { norm_phase(TID, p, p->out, HC, p->in[10] + l * D, modl, 3, M_ALL); }
        else if (KIND(6)) { pg8::Gemm g{XN, D, (const bf16_t*)(wb + WB_INA), M_ALL, WA_N, D, 0, 0}; pg8::StaticOrder S; S.init(M_ALL, WA_N, G, cb); EpiStore E{WA, WA_N};
            pg8::gemm_phase<EpiStore, pg8::StaticOrder, true, true>(TID, ldsl, g, S, E);
            S5L L5{p->in[14] + l * 4096, p->in[15] + l * 4096, p->in[16] + l * 64, p->in[17] + (size_t)l * 65536, p->in[18] + (size_t)l * 65536,
                   p->in[19] + (size_t)l * 65536, p->in[20] + (size_t)l * 65536, p->in[21] + l * 512};
            const int nfull = (M_ALL / 256) * (WA_N / 256) - 3 * G;
            if (nfull > 0 && nfull < G) s5_pre_phase(TID, p, L5, lds, nfull, G - nfull); else s5_pre_phase(TID, p, L5, lds, 0, G); }
        else if (KIND(7) || KIND(8) || KIND(10)) {
            S5L L5{p->in[14] + l * 4096, p->in[15] + l * 4096, p->in[16] + l * 64, p->in[17] + (size_t)l * 65536, p->in[18] + (size_t)l * 65536,
                   p->in[19] + (size_t)l * 65536, p->in[20] + (size_t)l * 65536, p->in[21] + l * 512};
            if (kind == 7) { mlanorm_phase(TID, p, p->in[24] + l * 256, p->in[26] + l * 128); s5_local_phase(TID, p, L5); }
            else if (kind == 8) { s5_carry_phase(TID, p, L5);
                pg8::Gemm g{WA + C_CQ, WA_N, (const bf16_t*)(wb + WB_UQ), M_ALL, 768, 256, 0, 0}; pg8::StaticOrder S; S.init(M_ALL, 768, G, cb); EpiStore E{MLAQ, 768};
                pg8::gemm_phase<EpiStore, pg8::StaticOrder, true, true>(TID, ldsl, g, S, E);
                pg8::Gemm g2{WA + C_CKV, WA_N, (const bf16_t*)(wb + WB_UKV), M_ALL, 1024, 128, 0, 0}; pg8::StaticOrder S2; S2.init(M_ALL, 1024, G, cb); EpiStore E2{MLAKV, 1024};
                pg8::gemm_phase<EpiStore, pg8::StaticOrder, true, true>(TID, ldsl, g2, S2, E2); }
            else { AttnP AP{WA, MLAQ, MLAKV, Y, p->in[12] + l * 3720, p->in[13] + l * 8}; attn_phase(TID, lds, AP, last ? 16 : 17);
                s5_out_phase(TID, p, L5, last); }
        }
        else if (KIND(11)) { pg8::Gemm g{G5, 512, (const bf16_t*)(wb + WB_GLU), Mpost, 512, 512, 0, 0}; pg8::StaticOrder S; S.init(Mpost, 512, G, cb); EpiGlu E{G5, p->in[23] + l * 512, Y};
            pg8::gemm_phase<EpiGlu, pg8::StaticOrder, true, true>(TID, ldsl, g, S, E); wprep_phase(TID, p, lds, l, 1); }
        else if (KIND(12)) { pg8::Gemm g{Y, 2048, (const bf16_t*)(wb + WB_BR), M_LAT, 4096, 512, 4, 512}; pg8::StaticOrder S; S.init(M_LAT, 4096, G, cb); EpiStore E{PB, 4096};
            pg8::gemm_phase<EpiStore, pg8::StaticOrder, true, true>(TID, ldsl, g, S, E);
            if (!last) mini_pgemm(TID, lds, Y, (const bf16_t*)(wb + WB_BR), PB); }
        else if (KIND(13)) { pg8::Gemm g{XN, D, (const bf16_t*)(wb + WB_G), M_LAT, 4096, D, 0, 0}; pg8::StaticOrder S; S.init(M_LAT, 4096, G, cb); EpiMerge E{PB, MB};
            pg8::gemm_phase<EpiMerge, pg8::StaticOrder, true, true>(TID, ldsl, g, S, E);
            if (!last) mini_merge(TID, lds, XN, (const bf16_t*)(wb + WB_G), PB, MB); }
        else if (KIND(14)) { pg8::Gemm g{MB, D, (const bf16_t*)(wb + WB_OUT), M_LAT, D, D, 0, 0}; pg8::StaticOrder S; S.init(M_LAT, D, G, cb);
            EpiResid E{p->out, HC, p->out, HC, modl + 5 * 1024, 1.0f};
            pg8::gemm_phase<EpiResid, pg8::StaticOrder, true, true>(TID, ldsl, g, S, E);
            if (!last) mini_resid(TID, lds, MB, D, (const bf16_t*)(wb + WB_OUT), D, HC, HC, modl + (size_t)(4 * 9 + 5) * 1024, 1.0f); }
        else if (KIND(15)) { norm_phase(TID, p, p->out, HC, p->in[30] + l * D, modl, 6, Mpost); }
        else if (KIND(16)) { pg8::Gemm g{XN, D, (const bf16_t*)(wb + WB_GU), Mpost, 5632, D, 0, 0}; pg8::StaticOrder S; S.init(Mpost, 5632, G, cb); EpiSwiglu E{ACT};
            pg8::gemm_phase<EpiSwiglu, pg8::StaticOrder, true, true>(TID, ldsl, g, S, E); }
        else if (KIND(17)) { pg8::Gemm g{ACT, DFF, (const bf16_t*)(wb + WB_DN), M_LAT, D, DFF, 0, 0}; pg8::StaticOrder S; S.init(M_LAT, D, G, cb);
            EpiResid E{p->out, HC, p->out, HC, modl + 8 * 1024, 0.5f};
            pg8::gemm_phase<EpiResid, pg8::StaticOrder, true, true>(TID, ldsl, g, S, E);
            if (!last) mini_resid(TID, lds, ACT, DFF, (const bf16_t*)(wb + WB_DN), DFF, HC, HC, modl + (size_t)(4 * 9 + 8) * 1024, 0.5f); }
        else if (KIND(18)) { final_phase(TID, p); }
#undef KIND
#undef MOD
#undef HC
#undef XN
#undef Y
#undef G5
#undef WA
#undef MLAQ
#undef MLAKV
#undef ACT
#undef PB
#undef MB
#undef wb
#undef modl
        if (ph + 1 < ph_hi) { if (ph_lo < 0) grid.sync(); else xcd_barrier(xbar); }
    }
}

extern "C" void kernel_launch(void* const* d_in, const int* in_sizes, int n_in, void* d_out, int out_size, void* d_ws, size_t ws_size, hipStream_t stream) {
    static int grid = 0;
    if (grid == 0) {
        if (n_in != 35 || out_size != M_LAT * D || ws_size < WS_END) { fprintf(stderr, "kernel_launch: unexpected shapes (n_in %d out %d ws %zu need %zu)\n", n_in, out_size, ws_size, (size_t)WS_END); grid = -1; return; }
        int dev = 0, cus = 0, per_cu = 0;
        hipGetDevice(&dev); hipDeviceGetAttribute(&cus, hipDeviceAttributeMultiprocessorCount, dev);
        if (hipFuncSetAttribute((const void*)fwd_kernel, hipFuncAttributeMaxDynamicSharedMemorySize, LDS_BYTES) != hipSuccess) { fprintf(stderr, "kernel_launch: hipFuncSetAttribute failed\n"); grid = -1; return; }
        if (hipOccupancyMaxActiveBlocksPerMultiprocessor(&per_cu, (const void*)fwd_kernel, NTHREADS, LDS_BYTES) != hipSuccess || per_cu < 1) { fprintf(stderr, "kernel_launch: occupancy query failed (%d)\n", per_cu); (void)hipGetLastError(); per_cu = 1; }
        grid = cus * 1;
        if (grid < 8) grid = 8;
    }
    if (grid < 0) return;
    if (hipMemsetAsync((char*)d_ws, 0, WS_CTL + CTL_BYTES, stream) != hipSuccess) { fprintf(stderr, "kernel_launch: memset failed\n"); return; }
    KP a{};
    for (int i = 0; i < 35; ++i) a.in[i] = (const float*)d_in[i];
    a.out = (float*)d_out; a.ws = (unsigned char*)d_ws; a.ph_lo = 0; a.ph_hi = N_PHASES;
    void* args[] = {&a};
    hipError_t e = hipLaunchCooperativeKernel((const void*)fwd_kernel, dim3(grid), dim3(NTHREADS), args, LDS_BYTES, stream);
    if (e != hipSuccess) fprintf(stderr, "cooperative launch failed: %s (grid %d)\n", hipGetErrorString(e), grid);
}
```

```cpp
#include <hip/hip_runtime.h>
#include <hip/hip_cooperative_groups.h>
#include <cstdio>
#include <cstdint>
namespace cg = cooperative_groups;

namespace pg8 {
#define PG8_LAS __attribute__((address_space(3)))
typedef unsigned short bf16_t;
typedef short bf16x8 __attribute__((ext_vector_type(8)));
typedef short s16x4 __attribute__((ext_vector_type(4)));
typedef float f32x4 __attribute__((ext_vector_type(4)));
typedef unsigned u32x4 __attribute__((ext_vector_type(4)));
typedef unsigned u32x2 __attribute__((ext_vector_type(2)));
constexpr int BM = 256, BK = 64, HALF = 128, HTB = HALF * BK * 2, STAGE_BYTES = 8 * HTB, NXCD = 8, WGM = 8;

__host__ __device__ __forceinline__ int lds_byte(int r, int c) { const int st = (r >> 4) * 2 + (c >> 5), rr = r & 15, cc = c & 31, ob = rr * 64 + cc * 2; return st * 1024 + (ob ^ (((ob >> 9) & 1) << 5)); }
__host__ __device__ __forceinline__ void stage_rc(int b, int& R, int& C) { const int st = b / 1024, sb = b % 1024, swz = sb ^ (((sb >> 9) & 1) << 5); R = (st >> 1) * 16 + swz / 64; C = (st & 1) * 32 + (swz % 64) / 2; }

__host__ __device__ __forceinline__ int perm32(int rho) { const int n = rho >> 4, i = rho & 15; return 8 * (i >> 2) + 4 * n + (i & 3); }
struct Unit { int pm, pn; };
struct Gemm { const bf16_t* A; int lda; const bf16_t* Bt; int M, N, K; int a_div; int a_stride; };

struct StaticOrder {
    int nM, nN, nwg, G, c;
    __host__ __device__ void init(int M, int N, int G_, int c_) { nM = M / BM; nN = N / BM; nwg = nM * nN; G = G_; c = c_; }
    __host__ __device__ bool next(int i, Unit& u) const {
        const long L = (long)i * G + c; if (L >= nwg) return false;
        int wgid = (int)L; { const int q = nwg / NXCD, r = nwg % NXCD, xcd = wgid % NXCD, off = wgid / NXCD; wgid = (xcd < r ? xcd * (q + 1) : r * (q + 1) + (xcd - r) * q) + off; }
        const int nig = WGM * nN, gid = wgid / nig, fm = gid * WGM, gsz = (nM - fm) < WGM ? (nM - fm) : WGM;
        u.pm = fm + ((wgid % nig) % gsz); u.pn = (wgid % nig) / gsz; return true;
    }
};
__device__ __forceinline__ unsigned cvt_pk_bf16(float lo, float hi) { unsigned r; asm volatile("v_cvt_pk_bf16_f32 %0, %1, %2" : "=v"(r) : "v"(lo), "v"(hi)); return r; }

template <class Epi, class Sched, bool ALIGN_EPI = false, bool SP2 = false>
__device__ __forceinline__ void gemm_phase(const int TID, PG8_LAS unsigned char* lds, const Gemm g, const Sched& S, const Epi& E) {
    const int tid = TID, wid = __builtin_amdgcn_readfirstlane(tid >> 6), lane = tid & 63, wr = wid >> 2, wc = wid & 3, fr = lane & 15, fq = lane >> 4;
    int K = g.K, lda = g.lda; asm volatile("" : "+s"(K), "+s"(lda));
    const int nt = K / BK;
    unsigned voffA[2], voffB[2];
#pragma unroll
    for (int i = 0; i < 2; ++i) { int R, C; stage_rc(tid * 16 + i * 8192, R, C);
        const int Rb = Epi::PERM ? ((R & ~31) + perm32(R & 31)) : R;
        voffA[i] = (unsigned)(R * lda + C) * 2u; voffB[i] = (unsigned)(Rb * K + C) * 2u; }
    const size_t kstep = (size_t)(BK * 2);
    const size_t hstepA = (size_t)HALF * lda * 2, hstepB = (size_t)HALF * K * 2;
    const size_t tstepA = 2 * hstepA, tstepB = 2 * hstepB;
    const unsigned ldsw = (unsigned)wid * 1024u;
    const int aoff = lds_byte(wr * 64 + fr, fq * 8), boff = lds_byte(wc * 32 + fr, fq * 8);
#define PG8_ABASE(u) ((const char*)g.A + (size_t)(u).pm * tstepA + (g.a_div ? (size_t)((u).pn / g.a_div) * (size_t)g.a_stride * 2 : (size_t)0))
#define PG8_SA(b, h) (((b) * 2 + (h)) * HTB)
#define PG8_SB(b, h) ((4 + (b) * 2 + (h)) * HTB)
#define PG8_STAGE(bufoff, gbase, voff) do { _Pragma("unroll") for (int _i = 0; _i < 2; ++_i) \
        __builtin_amdgcn_global_load_lds((const unsigned*)((const char*)(gbase) + (voff)[_i]), (PG8_LAS unsigned*)(lds + (bufoff) + ldsw + _i * 8192), 16, 0, 0); } while (0)
#define PG8_LDA(dst, b, h) do { _Pragma("unroll") for (int m = 0; m < 4; ++m) _Pragma("unroll") for (int k = 0; k < 2; ++k) dst[m][k] = *(const PG8_LAS bf16x8*)(lds + PG8_SA(b, h) + aoff + m * 2048 + k * 1024); } while (0)
#define PG8_LDB(dst, b, h) do { _Pragma("unroll") for (int n = 0; n < 2; ++n) _Pragma("unroll") for (int k = 0; k < 2; ++k) dst[n][k] = *(const PG8_LAS bf16x8*)(lds + PG8_SB(b, h) + boff + n * 2048 + k * 1024); } while (0)
#define PG8_MMA(ai, bj, At, Bt) do { __builtin_amdgcn_s_setprio(1); _Pragma("unroll") for (int m = 0; m < 4; ++m) _Pragma("unroll") for (int n = 0; n < 2; ++n) _Pragma("unroll") for (int k = 0; k < 2; ++k) \
        acc[ai][bj][m][n] = __builtin_amdgcn_mfma_f32_16x16x32_bf16(Bt[n][k], At[m][k], acc[ai][bj][m][n], 0, 0, 0); __builtin_amdgcn_s_setprio(0); } while (0)
#define PG8_WAIT_V(n) asm volatile("s_waitcnt vmcnt(" #n ")" ::: "memory")
#define PG8_WAIT_L(n) asm volatile("s_waitcnt lgkmcnt(" #n ")" ::: "memory")
#define PG8_BAR __builtin_amdgcn_s_barrier()
#define PG8_SCHED __builtin_amdgcn_sched_barrier(0)
    Unit cur, nxt; int ui = 0;
    if (!S.next(0, cur)) return;
    f32x4 acc[2][2][4][2];
#pragma unroll
    for (int a = 0; a < 2; ++a)
#pragma unroll
        for (int b = 0; b < 2; ++b)
#pragma unroll
            for (int m = 0; m < 4; ++m)
#pragma unroll
                for (int n = 0; n < 2; ++n) acc[a][b][m][n] = (f32x4){0.f, 0.f, 0.f, 0.f};
    bf16x8 At[4][2], B0[2][2], B1[2][2];
    const char* cA = PG8_ABASE(cur); const char* cB = (const char*)g.Bt + (size_t)cur.pn * tstepB;
    if constexpr (SP2) {
        PG8_STAGE(PG8_SB(0, 0), cB, voffB); PG8_STAGE(PG8_SB(0, 1), cB + hstepB, voffB); PG8_STAGE(PG8_SA(0, 0), cA, voffA); PG8_STAGE(PG8_SA(0, 1), cA + hstepA, voffA);
        if (wr == 1) PG8_BAR;
        PG8_WAIT_V(2); PG8_BAR;
        PG8_STAGE(PG8_SB(1, 0), cB + kstep, voffB); PG8_STAGE(PG8_SA(1, 0), cA + kstep, voffA); PG8_STAGE(PG8_SB(1, 1), cB + hstepB + kstep, voffB);
        PG8_WAIT_V(6); PG8_BAR;
    } else {
        PG8_STAGE(PG8_SB(0, 0), cB, voffB); PG8_STAGE(PG8_SA(0, 0), cA, voffA); PG8_STAGE(PG8_SB(0, 1), cB + hstepB, voffB); PG8_STAGE(PG8_SA(0, 1), cA + hstepA, voffA);
        if (wr == 1) PG8_BAR;
        PG8_WAIT_V(4); PG8_BAR;
        PG8_STAGE(PG8_SB(1, 0), cB + kstep, voffB); PG8_STAGE(PG8_SA(1, 0), cA + kstep, voffA); PG8_STAGE(PG8_SB(1, 1), cB + hstepB + kstep, voffB);
        PG8_WAIT_V(6); PG8_BAR;
    }
    for (;;) {
        const bool has_next = S.next(ui + 1, nxt);
        const char* nA = has_next ? PG8_ABASE(nxt) : cA; const char* nB = has_next ? (const char*)g.Bt + (size_t)nxt.pn * tstepB : cB;
        for (int t = 0; t < nt; t += 2) {
            const bool last = (t == nt - 2);
            const char* a1 = cA + (size_t)(t + 1) * kstep;
            const char* a2 = last ? nA : cA + (size_t)(t + 2) * kstep; const char* b2 = last ? nB : cB + (size_t)(t + 2) * kstep;
            const char* a3 = a2 + kstep; const char* b3 = b2 + kstep;
            if constexpr (SP2) {
            PG8_LDB(B0, 0, 0); PG8_LDB(B1, 0, 1); PG8_SCHED; PG8_LDA(At, 0, 0); PG8_STAGE(PG8_SA(1, 1), a1 + hstepA, voffA);
            PG8_WAIT_V(8); PG8_WAIT_L(0); PG8_BAR; PG8_MMA(0, 0, At, B0); PG8_MMA(0, 1, At, B1); PG8_BAR; PG8_SCHED;
            PG8_LDA(At, 0, 1); PG8_STAGE(PG8_SB(0, 0), b2, voffB); PG8_STAGE(PG8_SB(0, 1), b2 + hstepB, voffB); PG8_STAGE(PG8_SA(0, 0), a2, voffA);
            PG8_WAIT_V(8); PG8_WAIT_L(0); PG8_BAR; PG8_MMA(1, 0, At, B0); PG8_MMA(1, 1, At, B1); PG8_BAR; PG8_SCHED;
            PG8_LDB(B0, 1, 0); PG8_LDB(B1, 1, 1); PG8_SCHED; PG8_LDA(At, 1, 0); PG8_STAGE(PG8_SA(0, 1), a2 + hstepA, voffA);
            PG8_WAIT_V(8); PG8_WAIT_L(0); PG8_BAR; PG8_MMA(0, 0, At, B0); PG8_MMA(0, 1, At, B1); PG8_BAR; PG8_SCHED;
            PG8_LDA(At, 1, 1); PG8_STAGE(PG8_SB(1, 0), b3, voffB); PG8_STAGE(PG8_SB(1, 1), b3 + hstepB, voffB); PG8_STAGE(PG8_SA(1, 0), a3, voffA);
            PG8_WAIT_V(8); PG8_WAIT_L(0); PG8_BAR; PG8_MMA(1, 0, At, B0); PG8_MMA(1, 1, At, B1); PG8_BAR; PG8_SCHED;
            } else {
            PG8_LDB(B0, 0, 0); PG8_SCHED; PG8_LDA(At, 0, 0); PG8_STAGE(PG8_SA(1, 1), a1 + hstepA, voffA);
            PG8_WAIT_L(8); PG8_BAR; PG8_WAIT_L(0); PG8_MMA(0, 0, At, B0); PG8_BAR; PG8_SCHED;
            PG8_LDB(B1, 0, 1); PG8_STAGE(PG8_SB(0, 0), b2, voffB);
            PG8_BAR; PG8_WAIT_L(0); PG8_MMA(0, 1, At, B1); PG8_BAR;
            PG8_LDA(At, 0, 1); PG8_STAGE(PG8_SA(0, 0), a2, voffA);
            PG8_BAR; PG8_WAIT_L(0); PG8_MMA(1, 0, At, B0); PG8_BAR; PG8_SCHED;
            PG8_STAGE(PG8_SB(0, 1), b2 + hstepB, voffB);
            PG8_WAIT_V(6); PG8_BAR; PG8_MMA(1, 1, At, B1); PG8_BAR;
            PG8_LDB(B0, 1, 0); PG8_SCHED; PG8_LDA(At, 1, 0); PG8_STAGE(PG8_SA(0, 1), a2 + hstepA, voffA);
            PG8_WAIT_L(8); PG8_BAR; PG8_WAIT_L(0); PG8_MMA(0, 0, At, B0); PG8_BAR; PG8_SCHED;
            PG8_LDB(B1, 1, 1); PG8_STAGE(PG8_SB(1, 0), b3, voffB);
            PG8_BAR; PG8_WAIT_L(0); PG8_MMA(0, 1, At, B1); PG8_BAR;
            PG8_LDA(At, 1, 1); PG8_STAGE(PG8_SA(1, 0), a3, voffA);
            PG8_BAR; PG8_WAIT_L(0); PG8_MMA(1, 0, At, B0); PG8_BAR; PG8_SCHED;
            PG8_STAGE(PG8_SB(1, 1), b3 + hstepB, voffB);
            PG8_WAIT_V(6); PG8_BAR; PG8_MMA(1, 1, At, B1); PG8_BAR;
            }
        }
        if constexpr (ALIGN_EPI) { if (wr == 0) PG8_BAR; }
        E(acc, cur, wr, wc, fr, fq);
        if (!has_next) break;
#pragma unroll
        for (int a = 0; a < 2; ++a)
#pragma unroll
            for (int b = 0; b < 2; ++b)
#pragma unroll
                for (int m = 0; m < 4; ++m)
#pragma unroll
                    for (int n = 0; n < 2; ++n) acc[a][b][m][n] = (f32x4){0.f, 0.f, 0.f, 0.f};
        cur = nxt; cA = nA; cB = nB; ++ui;
        if constexpr (ALIGN_EPI) { if (wr == 1) PG8_BAR; }
    }
    PG8_WAIT_V(0);
    if constexpr (!ALIGN_EPI) { if (wr == 0) PG8_BAR; }
    PG8_BAR;
#undef PG8_ABASE
#undef PG8_SA
#undef PG8_SB
#undef PG8_STAGE
#undef PG8_LDA
#undef PG8_LDB
#undef PG8_MMA
#undef PG8_WAIT_V
#undef PG8_WAIT_L
#undef PG8_BAR
#undef PG8_SCHED
}
}

using pg8::bf16_t; using pg8::bf16x8; using pg8::s16x4; using pg8::f32x4; using pg8::u32x4; using pg8::u32x2; using pg8::cvt_pk_bf16; using pg8::Unit;

constexpr int D = 1024, BATCH = 4, SEQ = 4096, CTX = 256, DFF = 2816, NMOD = 9;
constexpr int M_LAT = BATCH * SEQ, M_ALL = M_LAT + BATCH * CTX;
constexpr int WA_N = 3328, INCOLS = 7328;
constexpr int C_NAQ = 0, C_NAK = 512, C_NAV = 1024, C_SWQ = 1536, C_SWK = 2048, C_SWV = 2176, C_S5U = 2304, C_CQ = 2816, C_CKV = 3072, C_KR = 3200;
constexpr float EPS = 1e-6f, LOG2E = 1.4426950408889634f;
constexpr int NTHREADS = 512, NWAVES = 8;
constexpr int LDS_BYTES = 147456;

constexpr size_t MiB = 1u << 20;
constexpr size_t WS_MOD = 0;
constexpr size_t WS_CTL = 512 * 1024, CTL_BYTES = 16384;
constexpr size_t WS_HC = 1 * MiB;
constexpr size_t WS_S5 = 5 * MiB;
constexpr size_t WS_WB = 14 * MiB;
constexpr size_t WB_GU = 0, WB_DN = 11 * MiB, WB_INA = WB_DN + 5632 * 1024, WB_G = WB_INA + 6656 * 1024, WB_UQ = WB_G + 8 * MiB,
                 WB_UKV = WB_UQ + 384 * 1024, WB_BR = WB_UKV + 256 * 1024, WB_OUT = WB_BR + 4 * MiB, WB_GLU = WB_OUT + 2 * MiB, WB_END = WB_GLU + 512 * 1024;
static_assert(WB_END <= 39 * MiB, "weights");
constexpr size_t WS_G5 = 53 * MiB;
constexpr size_t WS_XN = 70 * MiB;
constexpr size_t WS_Y = 104 * MiB;
constexpr size_t WS_BIG = 172 * MiB;
constexpr size_t BIG_WA = 0, BIG_MLAQ = (size_t)M_ALL * WA_N * 2, BIG_MLAKV = BIG_MLAQ + (size_t)M_ALL * 768 * 2, BIG_END = BIG_MLAKV + (size_t)M_ALL * 1024 * 2;
constexpr size_t BIG_P = 0, BIG_MB = (size_t)M_ALL * 4096 * 2;
static_assert(BIG_MB + (size_t)M_ALL * 1024 * 2 <= BIG_END, "overlay");
constexpr size_t WS_KERN = WS_BIG + BIG_END;
constexpr size_t WS_SBH = WS_KERN + 2 * MiB;
constexpr size_t WS_END = WS_SBH + 5 * MiB;
constexpr int KSPLIT = 16;

#define DEV __device__ __forceinline__
DEV float bf2f(unsigned short v) { return __uint_as_float((unsigned)v << 16); }
DEV float bflo(unsigned v) { return __uint_as_float(v << 16); }
DEV float bfhi(unsigned v) { return __uint_as_float(v & 0xffff0000u); }
DEV unsigned short f2bf(float f) { return (unsigned short)(cvt_pk_bf16(f, 0.f) & 0xffffu); }
DEV float sigmoidf_(float x) { return __builtin_amdgcn_rcpf(1.f + __expf(-x)); }
DEV float shflx(float v, int lane, int m) { return __int_as_float(__builtin_amdgcn_ds_bpermute((lane ^ m) << 2, __float_as_int(v))); }
DEV float wave_sum(float v, int lane) {
#pragma unroll
    for (int o = 1; o < 64; o <<= 1) v += shflx(v, lane, o);
    return v;
}
DEV int clampi(int v, int lo, int hi) { return v < lo ? lo : (v > hi ? hi : v); }

struct KP {
    const float* in[35];
    float* out; unsigned char* ws;
    int ph_lo, ph_hi;
};
typedef const __attribute__((address_space(4))) KP* KPP;

struct EpiSwiglu {
    static constexpr bool PERM = true;
    bf16_t* O;
    DEV void operator()(const f32x4 (&acc)[2][2][4][2], const Unit& u, int wr, int wc, int fr, int fq) const {
#pragma unroll
        for (int ai = 0; ai < 2; ++ai)
#pragma unroll
            for (int m = 0; m < 4; ++m) {
                const int row = u.pm * 256 + ai * 128 + wr * 64 + m * 16 + fr;
                float v[8];
#pragma unroll
                for (int n = 0; n < 2; ++n) { const f32x4 g = acc[ai][0][m][n], up = acc[ai][1][m][n];
#pragma unroll
                    for (int j = 0; j < 4; ++j) v[n * 4 + j] = g[j] * sigmoidf_(g[j]) * up[j]; }
                u32x4 w; w.x = cvt_pk_bf16(v[0], v[1]); w.y = cvt_pk_bf16(v[2], v[3]); w.z = cvt_pk_bf16(v[4], v[5]); w.w = cvt_pk_bf16(v[6], v[7]);
                *(u32x4*)(O + (size_t)row * DFF + u.pn * 128 + wc * 32 + fq * 8) = w;
            }
    }
};
struct EpiResid {
    static constexpr bool PERM = false;
    const float* in_lat; const float* in_ctx; float* out_lat; float* out_ctx; const float* gate;   float s;
    DEV void operator()(const f32x4 (&acc)[2][2][4][2], const Unit& u, int wr, int wc, int fr, int fq) const {
        const bool lat = u.pm < 64; const int v = lat ? (u.pm >> 4) : 4;
        const float* gv = gate + (size_t)v * 9 * 1024;
        const float* ib = lat ? in_lat : in_ctx - (size_t)M_LAT * D; float* ob = lat ? out_lat : out_ctx - (size_t)M_LAT * D;
#pragma unroll
        for (int bj = 0; bj < 2; ++bj)
#pragma unroll
            for (int n = 0; n < 2; ++n) {
                const int col = u.pn * 256 + bj * 128 + wc * 32 + n * 16 + fq * 4;
                const f32x4 g4 = *(const f32x4*)(gv + col) * s;
#pragma unroll
                for (int ai = 0; ai < 2; ++ai)
#pragma unroll
                    for (int m = 0; m < 4; ++m) {
                        const size_t off = (size_t)(u.pm * 256 + ai * 128 + wr * 64 + m * 16 + fr) * D + col;
                        const f32x4 b4 = *(const f32x4*)(ib + off);
                        *(f32x4*)(ob + off) = b4 + g4 * acc[ai][bj][m][n];
                    }
            }
    }
};
struct EpiStore {
    static constexpr bool PERM = true;
    bf16_t* O; int ldc;
    DEV void operator()(const f32x4 (&acc)[2][2][4][2], const Unit& u, int wr, int wc, int fr, int fq) const {
#pragma unroll
        for (int ai = 0; ai < 2; ++ai)
#pragma unroll
            for (int m = 0; m < 4; ++m) {
                bf16_t* rp = O + (size_t)(u.pm * 256 + ai * 128 + wr * 64 + m * 16 + fr) * ldc + u.pn * 256 + wc * 32 + fq * 8;
#pragma unroll
                for (int bj = 0; bj < 2; ++bj) { const f32x4 v0 = acc[ai][bj][m][0], v1 = acc[ai][bj][m][1];
                    u32x4 w; w.x = cvt_pk_bf16(v0[0], v0[1]); w.y = cvt_pk_bf16(v0[2], v0[3]); w.z = cvt_pk_bf16(v1[0], v1[1]); w.w = cvt_pk_bf16(v1[2], v1[3]);
                    *(u32x4*)(rp + bj * 128) = w; }
            }
    }
};
struct EpiGlu {
    static constexpr bool PERM = true;
    const bf16_t* G5; const float* bias; bf16_t* Y;
    DEV void operator()(const f32x4 (&acc)[2][2][4][2], const Unit& u, int wr, int wc, int fr, int fq) const {
#pragma unroll
        for (int bj = 0; bj < 2; ++bj) {
            const int col = u.pn * 256 + bj * 128 + wc * 32 + fq * 8;
            const f32x4 b0 = *(const f32x4*)(bias + col), b1 = *(const f32x4*)(bias + col + 4);
#pragma unroll
            for (int ai = 0; ai < 2; ++ai)
#pragma unroll
                for (int m = 0; m < 4; ++m) {
                    const int row = u.pm * 256 + ai * 128 + wr * 64 + m * 16 + fr;
                    const u32x4 gw = *(const u32x4*)(G5 + (size_t)row * 512 + col);
                    const f32x4 a0 = acc[ai][bj][m][0] + b0, a1 = acc[ai][bj][m][1] + b1;
                    u32x4 w;
                    w.x = cvt_pk_bf16(bflo(gw.x) * sigmoidf_(a0[0]), bfhi(gw.x) * sigmoidf_(a0[1])); w.y = cvt_pk_bf16(bflo(gw.y) * sigmoidf_(a0[2]), bfhi(gw.y) * sigmoidf_(a0[3]));
                    w.z = cvt_pk_bf16(bflo(gw.z) * sigmoidf_(a1[0]), bfhi(gw.z) * sigmoidf_(a1[1])); w.w = cvt_pk_bf16(bflo(gw.w) * sigmoidf_(a1[2]), bfhi(gw.w) * sigmoidf_(a1[3]));
                    *(u32x4*)(Y + (size_t)row * 2048 + 1024 + col) = w;
                }
        }
    }
};
struct EpiMerge {
    static constexpr bool PERM = false;
    const bf16_t* P; bf16_t* MB;
    DEV void operator()(const f32x4 (&acc)[2][2][4][2], const Unit& u, int wr, int wc, int fr, int fq) const {
        const int c = u.pn * 64 + wc * 16 + fq * 4;
#pragma unroll
        for (int ai = 0; ai < 2; ++ai)
#pragma unroll
            for (int m = 0; m < 4; ++m) {
                const int row = u.pm * 256 + ai * 128 + wr * 64 + m * 16 + fr;
                const bf16_t* pr = P + (size_t)row * 4096 + c;
                f32x4 v = (f32x4){0.f, 0.f, 0.f, 0.f};
#pragma unroll
                for (int bj = 0; bj < 2; ++bj)
#pragma unroll
                    for (int n = 0; n < 2; ++n) {
                        const u32x2 pw = *(const u32x2*)(pr + (2 * bj + n) * 1024); const f32x4 a = acc[ai][bj][m][n];
                        v[0] += bflo(pw.x) * sigmoidf_(a[0]); v[1] += bfhi(pw.x) * sigmoidf_(a[1]); v[2] += bflo(pw.y) * sigmoidf_(a[2]); v[3] += bfhi(pw.y) * sigmoidf_(a[3]);
                    }
                u32x2 w; w.x = cvt_pk_bf16(v[0], v[1]); w.y = cvt_pk_bf16(v[2], v[3]);
                *(u32x2*)(MB + (size_t)row * D + c) = w;
            }
    }
};

DEV const float* wsrc(const float* src, const float* src2, int map, int n) {
    switch (map) {
        case 1: { const int t = n >> 8, r = n & 255; return (r < 128) ? src + t * 128 + r : src2 + t * 128 + r - 128; }
        case 2: { if (n < 3232) return src + n; return nullptr; }
        case 3: { const int pn = n >> 8, loc = n & 255, bj = loc >> 7, wc = (loc >> 5) & 3, n16 = (loc >> 4) & 1, i = loc & 15; return src + 3232 + (2 * bj + n16) * 1024 + pn * 64 + wc * 16 + i; }
        case 5: { const int br = n >> 10, dd = n & 1023; return src + (size_t)br * 512 * 1024 + dd; }
        default: return src + n;
    }
}
DEV void wprep_item(const float* src, const float* src2, bf16_t* dst, int srcN, int K, int map, int item, float* scr  , int lane) {
    const int nkb = K / 64, nb = item / nkb, kb = item % nkb, k0 = kb * 64, n0 = nb * 64;
    const float* cp = wsrc(src, src2, map, n0 + (lane & 15) * 4);
    f32x4 v[16];
#pragma unroll
    for (int i = 0; i < 16; ++i) { const int kk = 4 * i + (lane >> 4); v[i] = cp ? *(const f32x4*)(cp + (size_t)(k0 + kk) * srcN) : (f32x4){0.f, 0.f, 0.f, 0.f}; }
#pragma unroll
    for (int i = 0; i < 16; ++i) { float* w = scr + (4 * i + (lane >> 4)) * 65 + (lane & 15) * 4; w[0] = v[i][0]; w[1] = v[i][1]; w[2] = v[i][2]; w[3] = v[i][3]; }
    asm volatile("s_waitcnt lgkmcnt(0)" ::: "memory");
    const int c = lane & 7;
#pragma unroll
    for (int j = 0; j < 8; ++j) { const int n = (lane >> 3) + 8 * j; const float* s = scr + (8 * c) * 65 + n;
        u32x4 o; o.x = cvt_pk_bf16(s[0 * 65], s[1 * 65]); o.y = cvt_pk_bf16(s[2 * 65], s[3 * 65]); o.z = cvt_pk_bf16(s[4 * 65], s[5 * 65]); o.w = cvt_pk_bf16(s[6 * 65], s[7 * 65]);
        *(u32x4*)(dst + (size_t)(n0 + n) * K + k0 + 8 * c) = o; }
    asm volatile("s_waitcnt lgkmcnt(0)" ::: "memory");
}
DEV void wprep_phase(const int TID, KPP p, unsigned char* lds, int layer, int which) {
    const int lane = TID & 63, wid = __builtin_amdgcn_readfirstlane(TID >> 6);
    __syncthreads();
    float* scr = (float*)(lds + wid * 16640);
    const int gw = wid * gridDim.x + blockIdx.x, NGW = gridDim.x * NWAVES;
    unsigned char* wbp = p->ws + WS_WB;
    const int total = which ? 2112 : 4880;
    for (int it0 = gw; it0 < total; it0 += NGW) {
        int it = __builtin_amdgcn_readfirstlane(it0);
        const float* src; const float* src2; bf16_t* dst; int srcN, K, map;
#define WJ(cnt, S, S2, OFF, SRCN, KK, MAP) if (it < (cnt)) { src = (S); src2 = (S2); dst = (bf16_t*)(wbp + (OFF)); srcN = (SRCN); K = (KK); map = (MAP); } else { it -= (cnt);
        if (which == 0) {
            WJ(1408, p->in[7] + (size_t)layer * D * DFF, p->in[8] + (size_t)layer * D * DFF, WB_GU, DFF, D, 1)
            WJ(704, p->in[9] + (size_t)layer * DFF * D, src, WB_DN, D, DFF, 0)
            WJ(832, p->in[11] + (size_t)layer * D * INCOLS, src, WB_INA, INCOLS, D, 2)
            WJ(1024, p->in[11] + (size_t)layer * D * INCOLS, src, WB_G, INCOLS, D, 3)
            WJ(48, p->in[25] + (size_t)layer * 256 * 768, src, WB_UQ, 768, 256, 0)
            WJ(32, p->in[27] + (size_t)layer * 128 * 1024, src, WB_UKV, 1024, 128, 0)
            WJ(512, p->in[28] + (size_t)layer * 4 * 512 * 1024, src, WB_BR, 1024, 512, 5)
            WJ(256, p->in[29] + (size_t)layer * D * D, src, WB_OUT, D, D, 0)
            { src = p->in[22] + (size_t)layer * 512 * 512; src2 = src; dst = (bf16_t*)(wbp + WB_GLU); srcN = 512; K = 512; map = 0; }
            }}}}}}}}
        } else {
            WJ(1408, p->in[31] + (size_t)layer * D * DFF, p->in[32] + (size_t)layer * D * DFF, WB_GU, DFF, D, 1)
            { src = p->in[33] + (size_t)layer * DFF * D; src2 = src; dst = (bf16_t*)(wbp + WB_DN); srcN = D; K = DFF; map = 0; }
            }
        }
#undef WJ
        wprep_item(src, src2, dst, srcN, K, map, it, scr, lane);
    }
    __syncthreads();
}

DEV void modp_phase(const int TID, KPP p, unsigned char* lds) {
    float* S = (float*)lds;
    const int tid = TID, lane = tid & 63, wid = tid >> 6;
    __syncthreads();
    for (int i = tid; i < 5 * 1024; i += NTHREADS) { const float x = (i < 4096) ? p->in[1][i] : p->in[3][i - 4096]; S[i] = x * sigmoidf_(x); }
    __syncthreads();
    float* MOD = (float*)(p->ws + WS_MOD);
    const int gw = wid * gridDim.x + blockIdx.x, NGW = gridDim.x * NWAVES;
    for (int it = gw; it < 2 * 144 * KSPLIT; it += NGW) {
        const int ks = it % KSPLIT, jb = (it / KSPLIT) % 144, l = it / (KSPLIT * 144);
        const float* W = p->in[4] + (size_t)l * D * 9216 + jb * 64 + lane;
        float a0 = 0.f, a1 = 0.f, a2 = 0.f, a3 = 0.f, a4 = 0.f;
#pragma unroll 8
        for (int kk = 0; kk < 64; ++kk) { const int k = ks * 64 + kk; const float w = W[(size_t)k * 9216];
            a0 += S[k] * w; a1 += S[1024 + k] * w; a2 += S[2048 + k] * w; a3 += S[3072 + k] * w; a4 += S[4096 + k] * w; }
        float* o = MOD + (size_t)l * 5 * 9216 + jb * 64 + lane;
        const float bs = (ks == 0) ? p->in[5][l * 9216 + jb * 64 + lane] : 0.f;
        atomicAdd(o, a0 + bs); atomicAdd(o + 9216, a1 + bs); atomicAdd(o + 2 * 9216, a2 + bs); atomicAdd(o + 3 * 9216, a3 + bs); atomicAdd(o + 4 * 9216, a4 + bs);
    }
    __syncthreads();
}
DEV void norm_phase(const int TID, KPP p, const float* hlat, const float* hctx, const float* w, const float* modl  , int ishift, int nrows) {
    bf16_t* XN = (bf16_t*)(p->ws + WS_XN);
    const int lane = TID & 63, wid = TID >> 6;
    const int gw = wid * gridDim.x + blockIdx.x, NGW = gridDim.x * NWAVES;
    for (int r = gw; r < nrows; r += NGW) {
        const float* xr = (r < M_LAT) ? hlat + (size_t)r * D : hctx + (size_t)(r - M_LAT) * D;
        const int v = (r < M_LAT) ? (r >> 12) : 4;
        const float* sh = modl + ((size_t)v * 9 + ishift) * 1024; const float* sc = sh + 1024;
        f32x4 x[4]; float ss = 0.f;
#pragma unroll
        for (int j = 0; j < 4; ++j) { x[j] = *(const f32x4*)(xr + j * 256 + lane * 4); ss += x[j][0] * x[j][0] + x[j][1] * x[j][1] + x[j][2] * x[j][2] + x[j][3] * x[j][3]; }
        const float rs = rsqrtf(wave_sum(ss, lane) * (1.f / D) + EPS);
#pragma unroll
        for (int j = 0; j < 4; ++j) {
            const int c = j * 256 + lane * 4;
            const f32x4 w4 = *(const f32x4*)(w + c), s4 = *(const f32x4*)(sh + c), c4 = *(const f32x4*)(sc + c);
            const f32x4 y = x[j] * rs * w4 * (c4 + 1.f) + s4;
            u32x2 o; o.x = cvt_pk_bf16(y[0], y[1]); o.y = cvt_pk_bf16(y[2], y[3]);
            *(u32x2*)(XN + (size_t)r * D + c) = o;
        }
    }
}
DEV void rope_inplace(bf16_t* x1p, bf16_t* x2p, float pos, float invf) {
    const float ang = pos * invf, cs = __cosf(ang), sn = __sinf(ang);
    const float a = bf2f(*x1p), b = bf2f(*x2p);
    *x1p = f2bf(a * cs - b * sn); *x2p = f2bf(b * cs + a * sn);
}
DEV void mlanorm_phase(const int TID, KPP p, const float* qw, const float* kvw) {
    bf16_t* WA = (bf16_t*)(p->ws + WS_BIG + BIG_WA);
    const int lane = TID & 63, wid = TID >> 6;
    const int gw = wid * gridDim.x + blockIdx.x, NGW = gridDim.x * NWAVES;
    for (int r = gw; r < M_ALL; r += NGW) {
        bf16_t* q = WA + (size_t)r * WA_N + C_CQ + lane * 4;
        const u32x2 qv = *(const u32x2*)q;
        const float q0 = bflo(qv.x), q1 = bfhi(qv.x), q2 = bflo(qv.y), q3 = bfhi(qv.y);
        const float rq = rsqrtf(wave_sum(q0 * q0 + q1 * q1 + q2 * q2 + q3 * q3, lane) * (1.f / 256.f) + EPS);
        const f32x4 w4 = *(const f32x4*)(qw + lane * 4);
        u32x2 o; o.x = cvt_pk_bf16(q0 * rq * w4[0], q1 * rq * w4[1]); o.y = cvt_pk_bf16(q2 * rq * w4[2], q3 * rq * w4[3]);
        *(u32x2*)q = o;
        bf16_t* k = WA + (size_t)r * WA_N + C_CKV + lane * 2;
        const unsigned kv = *(const unsigned*)k;
        const float k0 = bflo(kv), k1 = bfhi(kv);
        const float rk = rsqrtf(wave_sum(k0 * k0 + k1 * k1, lane) * (1.f / 128.f) + EPS);
        *(unsigned*)k = cvt_pk_bf16(k0 * rk * kvw[lane * 2], k1 * rk * kvw[lane * 2 + 1]);
        if (r < M_LAT) {
            const int t = r & 4095; const float prow = (float)(t >> 6), pcol = (float)(t & 63);
            bf16_t* wr_ = WA + (size_t)r * WA_N;
#pragma unroll
            for (int kq = 0; kq < 4; ++kq) { const int idx = lane + 64 * kq, hd = idx >> 5, pt = (idx >> 4) & 1, i = idx & 15;
                bf16_t* x = wr_ + C_SWQ + hd * 64 + pt * 32 + i;
                rope_inplace(x, x + 16, pt ? pcol : prow, __builtin_amdgcn_exp2f(-(float)i * (13.287712379549449f / 16.f))); }
            { const int hd = lane >> 5, pt = (lane >> 4) & 1, i = lane & 15;
                bf16_t* x = wr_ + C_SWK + hd * 64 + pt * 32 + i;
                rope_inplace(x, x + 16, pt ? pcol : prow, __builtin_amdgcn_exp2f(-(float)i * (13.287712379549449f / 16.f))); }
            if (lane < 16) { const int pt = lane >> 3, i = lane & 7;
                bf16_t* x = wr_ + C_KR + pt * 16 + i;
                rope_inplace(x, x + 8, pt ? pcol : prow, __builtin_amdgcn_exp2f(-(float)i * (13.287712379549449f / 8.f))); }
        }
    }
}
DEV void final_phase(const int TID, KPP p) {
    const float* w = p->in[34];
    const int lane = TID & 63, wid = TID >> 6;
    const int gw = wid * gridDim.x + blockIdx.x, NGW = gridDim.x * NWAVES;
    for (int r = gw; r < M_LAT; r += NGW) {
        float* xr = p->out + (size_t)r * D;
        f32x4 x[4]; float ss = 0.f;
#pragma unroll
        for (int j = 0; j < 4; ++j) { x[j] = *(const f32x4*)(xr + j * 256 + lane * 4); ss += x[j][0] * x[j][0] + x[j][1] * x[j][1] + x[j][2] * x[j][2] + x[j][3] * x[j][3]; }
        const float rs = rsqrtf(wave_sum(ss, lane) * (1.f / D) + EPS);
#pragma unroll
        for (int j = 0; j < 4; ++j) { const int c = j * 256 + lane * 4; *(f32x4*)(xr + c) = x[j] * rs * *(const f32x4*)(w + c); }
    }
}

struct S5L { const float *lre, *lim, *ldt, *bre, *bim, *cre, *cim, *dsk; };
DEV void s5_lambar(const S5L& L, int gi, int pp, float& lre, float& lim, float& dt, float& lbr, float& lbi) {
    lre = L.lre[gi * 64 + pp]; lim = L.lim[gi * 64 + pp]; dt = __expf(L.ldt[gi]);
    const float er = __expf(lre * dt), ang = lim * dt;
    lbr = er * cosf(ang); lbi = er * sinf(ang);
}
DEV void s5_coef(float lre, float lim, float lbr, float lbi, float& cr, float& ci) {
    const float ar = lbr - 1.f, ai = lbi, den = 1.f / (lre * lre + lim * lim);
    cr = (ar * lre + ai * lim) * den; ci = (ai * lre - ar * lim) * den;
}
DEV int s5_row(int b, int dir, int k, int s) {
    const int pos = k * 64 + s;
    if (dir == 0) return pos < 256 ? M_LAT + b * 256 + pos : b * 4096 + (pos - 256);
    return pos < 256 ? M_LAT + b * 256 + (255 - pos) : b * 4096 + (4095 - (pos - 256));
}
DEV void s5_pre_phase(const int TID, KPP p, const S5L& L, unsigned char* lds, const int b0, const int nbk) {
    if ((int)blockIdx.x < b0) return;
    const int bj = (int)blockIdx.x - b0;
    bf16_t* KERN = (bf16_t*)(p->ws + WS_KERN); bf16_t* W3 = (bf16_t*)(p->ws + WS_WB);
    float2* Cs = (float2*)lds; float2* Bs = Cs + 1024; float2* PWs = Bs + 1024;
    for (int it = bj; it < 256; it += nbk) {
        const int dg = it >> 2, dq = it & 3;
        __syncthreads();
        for (int idx = TID; idx < 1024; idx += NTHREADS) {
            { const int c = idx >> 6, pp = idx & 63; Cs[idx] = make_float2(L.cre[(dg * 16 + c) * 64 + pp], L.cim[(dg * 16 + c) * 64 + pp]); }
            { const int pp = idx >> 4, c2 = idx & 15; float lre, lim, dt, lbr, lbi, cr, ci; s5_lambar(L, dg, pp, lre, lim, dt, lbr, lbi); s5_coef(lre, lim, lbr, lbi, cr, ci);
              const float br = L.bre[(size_t)(dg * 64 + pp) * 16 + c2], bi = L.bim[(size_t)(dg * 64 + pp) * 16 + c2];
              Bs[idx] = make_float2(cr * br - ci * bi, cr * bi + ci * br); }
            { const int dd = idx >> 6, pp = idx & 63; const float d = (float)(dq * 16 + dd);
              const float lre = L.lre[dg * 64 + pp], lim = L.lim[dg * 64 + pp], dt = __expf(L.ldt[dg]);
              const float er = __expf(d * lre * dt), ang = d * lim * dt; PWs[idx] = make_float2(er * cosf(ang), er * sinf(ang)); }
        }
        __syncthreads();
        {
            const int c2h = TID & 1, c = (TID >> 1) & 15, dd = TID >> 5;
            float sum[8];
#pragma unroll
            for (int j = 0; j < 8; ++j) sum[j] = 0.f;
#pragma unroll 4
            for (int pp = 0; pp < 64; ++pp) { const float2 cc = Cs[c * 64 + pp], pw = PWs[dd * 64 + pp];
                const float gr = cc.x * pw.x - cc.y * pw.y, gi = cc.x * pw.y + cc.y * pw.x;
                const f32x4* bp = (const f32x4*)(Bs + pp * 16 + c2h * 8);
#pragma unroll
                for (int q = 0; q < 4; ++q) { const f32x4 b2 = bp[q]; sum[2 * q] += gr * b2[0] - gi * b2[1]; sum[2 * q + 1] += gr * b2[2] - gi * b2[3]; } }
            u32x4 w; w.x = cvt_pk_bf16(sum[0], sum[1]); w.y = cvt_pk_bf16(sum[2], sum[3]); w.z = cvt_pk_bf16(sum[4], sum[5]); w.w = cvt_pk_bf16(sum[6], sum[7]);
            *(u32x4*)(KERN + (size_t)((dg * 64 + dq * 16 + dd) * 16 + c) * 16 + c2h * 8) = w;
        }
    }
    __syncthreads();
    for (int un = (TID >> 6) * nbk + bj; un < 64 * 16; un += nbk * NWAVES) {
        const int pp = TID & 63, c = un & 15, dg = un >> 4;
        float lre, lim, dt, lbr, lbi; s5_lambar(L, dg, pp, lre, lim, dt, lbr, lbi);
        const float cr = L.cre[(dg * 16 + c) * 64 + pp], ci = L.cim[(dg * 16 + c) * 64 + pp];
        float pr = lbr, pi = lbi;
        bf16_t* o = W3 + (size_t)(dg * 64 * 16 + c) * 128 + pp;
#pragma unroll 4
        for (int e = 0; e < 64; ++e) {
            o[(size_t)e * 16 * 128] = f2bf(cr * pr - ci * pi); o[(size_t)e * 16 * 128 + 64] = f2bf(-(cr * pi + ci * pr));
            const float nr = pr * lbr - pi * lbi, ni = pr * lbi + pi * lbr; pr = nr; pi = ni;
        }
    }
}
DEV void s5_local_phase(const int TID, KPP p, const S5L& L) {
    const bf16_t* WA = (const bf16_t*)(p->ws + WS_BIG + BIG_WA); float2* SB = (float2*)(p->ws + WS_S5);
    const int lane = TID & 63, wid = __builtin_amdgcn_readfirstlane(TID >> 6), fr = lane & 15, fq = lane >> 4, sh = fq >> 1, c0 = (fq & 1) * 8;
    const int gw = wid * gridDim.x + blockIdx.x, NGW = gridDim.x * NWAVES;
    for (int it = gw; it < 768; it += NGW) {
        const int nh = it % 3, mbp = (it / 3) & 3, dg = it / 12, dir = dg >> 5, g = dg & 31, pp = mbp * 16 + fr;
        float lre, lim, dt, lbr, lbi, cr, ci; s5_lambar(L, dg, pp, lre, lim, dt, lbr, lbi); s5_coef(lre, lim, lbr, lbi, cr, ci);
        float bbr[8], bbi[8];
        { const f32x4* brp = (const f32x4*)(L.bre + (size_t)(dg * 64 + pp) * 16 + c0); const f32x4* bip = (const f32x4*)(L.bim + (size_t)(dg * 64 + pp) * 16 + c0);
#pragma unroll
          for (int q = 0; q < 2; ++q) { const f32x4 r4 = brp[q], i4 = bip[q];
#pragma unroll
              for (int j = 0; j < 4; ++j) { bbr[q * 4 + j] = cr * r4[j] - ci * i4[j]; bbi[q * 4 + j] = cr * i4[j] + ci * r4[j]; } } }
        const float l2r = lbr * lbr - lbi * lbi, l2i = 2.f * lbr * lbi;
        float pr = sh ? 1.f : lbr, pi = sh ? 0.f : lbi;
        const int NB = (nh < 2) ? 6 : 5, nb0 = nh * 6;
        const bf16_t* ub[6]; int kcol[6];
#pragma unroll
        for (int nb = 0; nb < 6; ++nb) { int col = (nb0 + nb) * 16 + fr; if (col > 271) col = 271; const int b = col / 68, k = col % 68;
            kcol[nb] = (b * 2 + dir) * 68 + k; ub[nb] = WA + (size_t)s5_row(b, dir, k, 0) * WA_N + C_S5U + g * 16 + c0; }
        const ptrdiff_t sstep = (dir == 0) ? (ptrdiff_t)WA_N : -(ptrdiff_t)WA_N;
        f32x4 are[6], aim[6];
#pragma unroll
        for (int nb = 0; nb < 6; ++nb) { are[nb] = (f32x4){0.f, 0.f, 0.f, 0.f}; aim[nb] = (f32x4){0.f, 0.f, 0.f, 0.f}; }
        bf16x8 Bc[6], Bn[6], Bm[6];
#pragma unroll
        for (int nb = 0; nb < 6; ++nb) { Bc[nb] = *(const bf16x8*)(ub[nb] + (ptrdiff_t)(62 + sh) * sstep); Bn[nb] = *(const bf16x8*)(ub[nb] + (ptrdiff_t)(60 + sh) * sstep); Bm[nb] = Bn[nb]; }
#pragma unroll 1
        for (int kc = 31; kc >= 0; --kc) {
            if (kc > 1) {
#pragma unroll
                for (int nb = 0; nb < 6; ++nb) if (nb < NB) Bm[nb] = *(const bf16x8*)(ub[nb] + (ptrdiff_t)(2 * kc - 4 + sh) * sstep);
            }
            u32x4 wr_, wi_;
            wr_.x = cvt_pk_bf16(pr * bbr[0] - pi * bbi[0], pr * bbr[1] - pi * bbi[1]); wr_.y = cvt_pk_bf16(pr * bbr[2] - pi * bbi[2], pr * bbr[3] - pi * bbi[3]);
            wr_.z = cvt_pk_bf16(pr * bbr[4] - pi * bbi[4], pr * bbr[5] - pi * bbi[5]); wr_.w = cvt_pk_bf16(pr * bbr[6] - pi * bbi[6], pr * bbr[7] - pi * bbi[7]);
            wi_.x = cvt_pk_bf16(pr * bbi[0] + pi * bbr[0], pr * bbi[1] + pi * bbr[1]); wi_.y = cvt_pk_bf16(pr * bbi[2] + pi * bbr[2], pr * bbi[3] + pi * bbr[3]);
            wi_.z = cvt_pk_bf16(pr * bbi[4] + pi * bbr[4], pr * bbi[5] + pi * bbr[5]); wi_.w = cvt_pk_bf16(pr * bbi[6] + pi * bbr[6], pr * bbi[7] + pi * bbr[7]);
            const bf16x8 Ar = __builtin_bit_cast(bf16x8, wr_), Ai = __builtin_bit_cast(bf16x8, wi_);
#pragma unroll
            for (int nb = 0; nb < 6; ++nb) if (nb < NB) {
                are[nb] = __builtin_amdgcn_mfma_f32_16x16x32_bf16(Ar, Bc[nb], are[nb], 0, 0, 0);
                aim[nb] = __builtin_amdgcn_mfma_f32_16x16x32_bf16(Ai, Bc[nb], aim[nb], 0, 0, 0);
            }
#pragma unroll
            for (int nb = 0; nb < 6; ++nb) { Bc[nb] = Bn[nb]; Bn[nb] = Bm[nb]; }
            const float nr = pr * l2r - pi * l2i, ni = pr * l2i + pi * l2r; pr = nr; pi = ni;
        }
#pragma unroll
        for (int nb = 0; nb < 6; ++nb) if (nb < NB) {
            float2* o = SB + (size_t)kcol[nb] * 2048 + g * 64 + mbp * 16 + fq * 4;
#pragma unroll
            for (int j = 0; j < 4; ++j) o[j] = make_float2(are[nb][j], aim[nb][j]);
        }
    }
}
DEV void s5_carry_phase(const int TID, KPP p, const S5L& L) {
    const float2* __restrict__ SB = (const float2*)(p->ws + WS_S5); bf16_t* __restrict__ SBH = (bf16_t*)(p->ws + WS_SBH);
    if (TID >= 64) return;
    for (int idx = blockIdx.x * 64 + TID; idx < 4 * 2 * 32 * 64; idx += gridDim.x * 64) {
        const int pp = idx & 63, g = (idx >> 6) & 31, dir = (idx >> 11) & 1, b = idx >> 12;
        float lre, lim, dt, ar, ai; s5_lambar(L, dir * 32 + g, pp, lre, lim, dt, ar, ai);
#pragma unroll
        for (int q = 0; q < 6; ++q) { const float nr = ar * ar - ai * ai, ni = 2.f * ar * ai; ar = nr; ai = ni; }
        float sr = 0.f, si = 0.f;
        const float2* base = SB + (size_t)((b * 2 + dir) * 68) * 2048 + g * 64 + pp;
        bf16_t* ob = SBH + (size_t)((b * 2 + dir) * 68) * 4096 + g * 128 + pp;
#pragma unroll 17
        for (int k = 0; k < 68; ++k) { const float2 e = base[(size_t)k * 2048];
            ob[(size_t)k * 4096] = f2bf(sr); ob[(size_t)k * 4096 + 64] = f2bf(si);
            const float nr = ar * sr - ai * si + e.x, ni = ar * si + ai * sr + e.y; sr = nr; si = ni; }
    }
}
DEV float gelu_tanh(float x) { const float z = 0.7978845608028654f * (x + 0.044715f * x * x * x); const float t = 1.f - 2.f * __builtin_amdgcn_rcpf(1.f + __expf(2.f * z)); return 0.5f * x * (1.f + t); }
DEV void s5_out_phase(const int TID, KPP p, const S5L& L, bool lastl) {
    const bf16_t* WA = (const bf16_t*)(p->ws + WS_BIG + BIG_WA); const bf16_t* SBH = (const bf16_t*)(p->ws + WS_SBH); bf16_t* G5 = (bf16_t*)(p->ws + WS_G5);
    const bf16_t* KERN = (const bf16_t*)(p->ws + WS_KERN); const bf16_t* W3 = (const bf16_t*)(p->ws + WS_WB);
    const int lane = TID & 63, wid = __builtin_amdgcn_readfirstlane(TID >> 6), fr = lane & 15, fq = lane >> 4, sh = fq >> 1, c0 = (fq & 1) * 8;
    const int gw = wid * gridDim.x + blockIdx.x, NGW = gridDim.x * NWAVES;
    const int NG = lastl ? 4 : 5, ncols = lastl ? 256 : 272;
    for (int it = gw; it < 32 * 16 * NG; it += NGW) {
        const int ng = it % NG, tg = (it / NG) & 15, g = it / (NG * 16), t0 = tg * 4;
        int rowb[4]; const bf16_t* sbf[4]; const bf16_t* sbr[4];
#pragma unroll
        for (int nb = 0; nb < 4; ++nb) { int col = (ng * 4 + nb) * 16 + fr; if (col >= ncols) col = ncols - 1;
            const int b = lastl ? (col >> 6) : (col / 68), tc = lastl ? 4 + (col & 63) : (col % 68);
            rowb[nb] = (tc < 4) ? M_LAT + b * 256 + tc * 64 : b * 4096 + (tc - 4) * 64;
            const int kr = (tc < 4) ? 3 - tc : 71 - tc;
            sbf[nb] = SBH + (size_t)(((b * 2 + 0) * 68 + tc) * 32 + g) * 128 + fq * 8; sbr[nb] = SBH + (size_t)(((b * 2 + 1) * 68 + kr) * 32 + g) * 128 + fq * 8; }
        const int nvalid = (ncols - ng * 64 + 15) >> 4;
        f32x4 acc[4][4];
#pragma unroll
        for (int ti = 0; ti < 4; ++ti)
#pragma unroll
            for (int nb = 0; nb < 4; ++nb) acc[ti][nb] = (f32x4){0.f, 0.f, 0.f, 0.f};
        const bf16_t* kf = KERN + (size_t)(g * 64 * 16 + fr) * 16 + c0; const bf16_t* kr_ = KERN + (size_t)((32 + g) * 64 * 16 + fr) * 16 + c0;
#define S5O_LOAD(Bs_, Af_, Ar_, kc_) do { const int _tq = 2 * (kc_) + sh; \
            _Pragma("unroll") for (int nb = 0; nb < 4; ++nb) Bs_[nb] = *(const bf16x8*)(WA + (size_t)(rowb[nb] + _tq) * WA_N + C_S5U + g * 16 + c0); \
            _Pragma("unroll") for (int ti = 0; ti < 4; ++ti) { const int _df = t0 + ti - _tq, _dr = _tq - t0 - ti; \
                u32x4 _a = *(const u32x4*)(kf + (size_t)(_df < 0 ? 0 : _df) * 256); if (_df < 0) _a = (u32x4){0u, 0u, 0u, 0u}; Af_[ti] = __builtin_bit_cast(bf16x8, _a); \
                u32x4 _b = *(const u32x4*)(kr_ + (size_t)(_dr < 0 ? 0 : _dr) * 256); if (_dr < 0) _b = (u32x4){0u, 0u, 0u, 0u}; Ar_[ti] = __builtin_bit_cast(bf16x8, _b); } } while (0)
#define S5O_MMA(Bs_, Af_, Ar_, kc_) do { \
            _Pragma("unroll") for (int ti = 0; ti < 4; ++ti) { const int t = t0 + ti; \
                if (t >= 2 * (kc_)) { _Pragma("unroll") for (int nb = 0; nb < 4; ++nb) if (nb < nvalid) acc[ti][nb] = __builtin_amdgcn_mfma_f32_16x16x32_bf16(Af_[ti], Bs_[nb], acc[ti][nb], 0, 0, 0); } \
                if (2 * (kc_) + 1 >= t) { _Pragma("unroll") for (int nb = 0; nb < 4; ++nb) if (nb < nvalid) acc[ti][nb] = __builtin_amdgcn_mfma_f32_16x16x32_bf16(Ar_[ti], Bs_[nb], acc[ti][nb], 0, 0, 0); } } } while (0)
        {
            bf16x8 B0[4], F0[4], R0[4], B1[4], F1[4], R1[4];
            S5O_LOAD(B0, F0, R0, 0);
#pragma unroll 1
            for (int kc = 0; kc < 32; kc += 2) {
                S5O_LOAD(B1, F1, R1, kc + 1);
                S5O_MMA(B0, F0, R0, kc);
                if (kc + 2 < 32) S5O_LOAD(B0, F0, R0, kc + 2);
                S5O_MMA(B1, F1, R1, kc + 1);
            }
        }
#undef S5O_LOAD
#undef S5O_MMA
#pragma unroll 1
        for (int dir = 0; dir < 2; ++dir)
#pragma unroll
            for (int kc2 = 0; kc2 < 4; ++kc2) {
                bf16x8 B[4];
#pragma unroll
                for (int nb = 0; nb < 4; ++nb) B[nb] = *(const bf16x8*)((dir ? sbr[nb] : sbf[nb]) + kc2 * 32);
#pragma unroll
                for (int ti = 0; ti < 4; ++ti) { const int t = t0 + ti, e = dir ? 63 - t : t;
                    const bf16x8 A = *(const bf16x8*)(W3 + (size_t)(((dir * 32 + g) * 64 + e) * 16 + fr) * 128 + kc2 * 32 + fq * 8);
#pragma unroll
                    for (int nb = 0; nb < 4; ++nb) if (nb < nvalid) acc[ti][nb] = __builtin_amdgcn_mfma_f32_16x16x32_bf16(A, B[nb], acc[ti][nb], 0, 0, 0); }
            }
        const f32x4 dsk = *(const f32x4*)(L.dsk + g * 16 + fq * 4);
#pragma unroll
        for (int nb = 0; nb < 4; ++nb) if (nb < nvalid)
#pragma unroll
            for (int ti = 0; ti < 4; ++ti) {
                const size_t row = (size_t)(rowb[nb] + t0 + ti);
                const u32x2 uw = *(const u32x2*)(WA + row * WA_N + C_S5U + g * 16 + fq * 4);
                const f32x4 a = acc[ti][nb];
                const float y0 = gelu_tanh(a[0] + dsk[0] * bflo(uw.x)), y1 = gelu_tanh(a[1] + dsk[1] * bfhi(uw.x)), y2 = gelu_tanh(a[2] + dsk[2] * bflo(uw.y)), y3 = gelu_tanh(a[3] + dsk[3] * bfhi(uw.y));
                u32x2 w; w.x = cvt_pk_bf16(y0, y1); w.y = cvt_pk_bf16(y2, y3);
                *(u32x2*)(G5 + row * 512 + g * 16 + fq * 4) = w;
            }
    }
}

struct AttnP { const bf16_t* WA; const bf16_t* MLAQ; const bf16_t* MLAKV; bf16_t* Y; const float* rpb; const float* sink; };
typedef float f32x16 __attribute__((ext_vector_type(16)));
DEV float half_max(float x) { auto q = __builtin_amdgcn_permlane32_swap(__float_as_uint(x), __float_as_uint(x), false, false); return fmaxf(__uint_as_float(q[0]), __uint_as_float(q[1])); }
DEV float half_sum(float x) { auto q = __builtin_amdgcn_permlane32_swap(__float_as_uint(x), __float_as_uint(x), false, false); return __uint_as_float(q[0]) + __uint_as_float(q[1]); }
template <int TYPE  >
DEV void attn_item(const int TID, unsigned char* lds, const AttnP& P, int b, int h, int qt) {
    constexpr int DQ = (TYPE == 2) ? 96 : 64, NC = DQ / 16, KPI = DQ + 8, VPI = 68, BUFSZ = 22016;
    float* rp = (float*)(lds + 2 * BUFSZ);
    const int tid = TID, lane = tid & 63, wid = __builtin_amdgcn_readfirstlane(tid >> 6), l31 = lane & 31, hi = lane >> 5;
    const bool cq = (qt == 16);
    const int qrow0 = cq ? M_LAT + b * 256 : b * 4096 + qt * 256;
    const bf16_t *Qp, *K0p, *Vp; int qpitch, kpitch;
    if (TYPE == 0) { Qp = P.WA + C_NAQ + h * 64; qpitch = WA_N; K0p = P.WA + C_NAK + h * 64; Vp = P.WA + C_NAV + h * 64; kpitch = WA_N; }
    else if (TYPE == 1) { Qp = P.WA + C_SWQ + h * 64; qpitch = WA_N; K0p = P.WA + C_SWK + (h >> 2) * 64; Vp = P.WA + C_SWV + (h >> 2) * 64; kpitch = WA_N; }
    else { Qp = P.MLAQ + h * 96; qpitch = 768; K0p = P.MLAKV + h * 128; Vp = P.MLAKV + h * 128 + 64; kpitch = 1024; }
    const bf16_t* K1p = P.WA + C_KR;
    int lo = 0, hi_t = 0, wlo = 0, whi = 0;
    const int qw = qt * 256 + wid * 32;
    if (!cq) {
        if (TYPE == 0) { lo = clampi(qt * 4 - 4, 0, 56); hi_t = clampi(qt * 4 + 3 - 4, 0, 56) + 8; wlo = clampi((qw >> 6) - 4, 0, 56); whi = wlo + 8; }
        else if (TYPE == 1) { lo = qt * 4 - 2; if (lo < 0) lo = 0; hi_t = qt * 4 + 6; if (hi_t > 64) hi_t = 64;
            wlo = (qw - 128 < 0 ? 0 : qw - 128) >> 6; whi = ((qw + 31 + 128) >> 6) + 1; if (whi > 64) whi = 64; }
        else { lo = 0; hi_t = 64; wlo = 0; whi = 64; }
    }
    const int nloc = hi_t - lo, nt = nloc + 4;
    const float sc = ((TYPE == 2) ? 0.10206207261596575f : 0.125f) * LOG2E;
    __syncthreads();
    if (TYPE == 0 && !cq && tid < 465) rp[tid] = P.rpb[h * 465 + tid] * LOG2E;
    const int qrow = qrow0 + wid * 32 + l31;
    bf16x8 Qf[NC];
#pragma unroll
    for (int c = 0; c < NC; ++c) {
        const u32x4 w = *(const u32x4*)(Qp + (size_t)qrow * qpitch + c * 16 + hi * 8);
        float v[8] = {bflo(w.x), bfhi(w.x), bflo(w.y), bfhi(w.y), bflo(w.z), bfhi(w.z), bflo(w.w), bfhi(w.w)};
        if (TYPE == 2 && c >= 4 && !cq) {
            const int t = qrow & 4095; const float pos = (float)((c == 5) ? (t & 63) : (t >> 6));
#pragma unroll
            for (int j = 0; j < 8; ++j) {
                const float other = shflx(v[j], lane, 32);
                const float ang = pos * __builtin_amdgcn_exp2f(-(float)j * (13.287712379549449f / 8.f)), cs = __cosf(ang), sn = __sinf(ang);
                v[j] = hi ? (v[j] * cs + other * sn) : (v[j] * cs - other * sn);
            }
        }
        u32x4 o; o.x = cvt_pk_bf16(v[0] * sc, v[1] * sc); o.y = cvt_pk_bf16(v[2] * sc, v[3] * sc); o.z = cvt_pk_bf16(v[4] * sc, v[5] * sc); o.w = cvt_pk_bf16(v[6] * sc, v[7] * sc);
        Qf[c] = __builtin_bit_cast(bf16x8, o);
    }
    f32x16 O[2]; float mrun, lrun;
#pragma unroll
    for (int db = 0; db < 2; ++db)
#pragma unroll
        for (int r = 0; r < 16; ++r) O[db][r] = 0.f;
    if (TYPE == 1) { mrun = P.sink[h] * LOG2E; lrun = (hi == 0) ? 1.f : 0.f; } else { mrun = -1e30f; lrun = 0.f; }
    const int qtok = qw + l31, qr = qtok >> 6, qc = qtok & 63, r0 = clampi(qr - 4, 0, 56), c0 = clampi(qc - 8, 0, 48);
    u32x4 kr0, kr1, vr; kr1 = (u32x4){0u, 0u, 0u, 0u};
    auto tile_row0 = [&](int i) { return (i < nloc) ? b * 4096 + (lo + i) * 64 : M_LAT + b * 256 + (i - nloc) * 64; };
#define ATT_PREFETCH(i) do { const int _r0 = tile_row0(i); \
        kr0 = *(const u32x4*)(K0p + (size_t)(_r0 + (tid >> 3)) * kpitch + (tid & 7) * 8); \
        if (TYPE == 2 && tid < 256) kr1 = *(const u32x4*)(K1p + (size_t)(_r0 + (tid >> 2)) * WA_N + (tid & 3) * 8); \
        vr = *(const u32x4*)(Vp + (size_t)(_r0 + (tid >> 3)) * kpitch + (tid & 7) * 8); } while (0)
#define ATT_WRITE(bufi) do { bf16_t* _Ks = (bf16_t*)(lds + (bufi) * BUFSZ); bf16_t* _Vt = (bf16_t*)(lds + (bufi) * BUFSZ + 64 * KPI * 2); \
        *(u32x4*)(_Ks + (tid >> 3) * KPI + (tid & 7) * 8) = kr0; \
        if (TYPE == 2 && tid < 256) *(u32x4*)(_Ks + (tid >> 2) * KPI + 64 + (tid & 3) * 8) = kr1; \
        bf16_t* vp = _Vt + ((tid & 7) * 8) * VPI + ((tid >> 3) ^ ((tid & 7) * 8));   \
        vp[0 * VPI] = (bf16_t)(vr.x & 0xffffu); vp[1 * VPI] = (bf16_t)(vr.x >> 16); vp[2 * VPI] = (bf16_t)(vr.y & 0xffffu); vp[3 * VPI] = (bf16_t)(vr.y >> 16); \
        vp[4 * VPI] = (bf16_t)(vr.z & 0xffffu); vp[5 * VPI] = (bf16_t)(vr.z >> 16); vp[6 * VPI] = (bf16_t)(vr.w & 0xffffu); vp[7 * VPI] = (bf16_t)(vr.w >> 16); } while (0)
    ATT_PREFETCH(0); ATT_WRITE(0); ATT_PREFETCH(1);
    __syncthreads();
    for (int i = 0; i < nt; ++i) {
        const bf16_t* Ks = (const bf16_t*)(lds + (i & 1) * BUFSZ); const bf16_t* Vt = (const bf16_t*)(lds + (i & 1) * BUFSZ + 64 * KPI * 2);
        const bool local = i < nloc; const int kt = lo + i;
        if (!(local && (kt < wlo || kt >= whi))) {
        f32x16 S[2];
#pragma unroll
        for (int kb = 0; kb < 2; ++kb) {
            bf16x8 Kf[NC];
#pragma unroll
            for (int c = 0; c < NC; ++c) Kf[c] = *(const bf16x8*)(Ks + (kb * 32 + l31) * KPI + c * 16 + hi * 8);
            __builtin_amdgcn_sched_barrier(0);
            f32x16 acc;
#pragma unroll
            for (int r = 0; r < 16; ++r) acc[r] = 0.f;
#pragma unroll
            for (int c = 0; c < NC; ++c) acc = __builtin_amdgcn_mfma_f32_32x32x16_bf16(Kf[c], Qf[c], acc, 0, 0, 0);
            S[kb] = acc;
            __builtin_amdgcn_sched_barrier(0);
        }
        u32x2 Vf[4][2];
#pragma unroll
        for (int ck = 0; ck < 4; ++ck) { const bf16_t* vp = Vt + l31 * VPI; const int sw = (l31 >> 3) * 8; Vf[ck][0] = *(const u32x2*)(vp + ((ck * 16 + hi * 4) ^ sw)); Vf[ck][1] = *(const u32x2*)(vp + ((ck * 16 + 8 + hi * 4) ^ sw)); }
        __builtin_amdgcn_sched_barrier(0);
        float mx = -1e30f;
#pragma unroll
        for (int kb = 0; kb < 2; ++kb)
#pragma unroll
            for (int r = 0; r < 16; ++r) {
                const int kk = kb * 32 + (r & 3) + 8 * (r >> 2) + 4 * hi;
                float t = S[kb][r];
                if (TYPE != 2 && local) {
                    if (TYPE == 0) { const bool ok = ((unsigned)(kt - r0) < 8u) && ((unsigned)(kk - c0) < 16u);
                        if (ok) t += rp[(kt - qr + 7) * 31 + (kk - qc + 15)]; else t = -1e30f; }
                    else if (TYPE == 1) { int dlt = qtok - (kt * 64 + kk); if (dlt < 0) dlt = -dlt; if (dlt > 128) t = -1e30f; }
                    S[kb][r] = t;
                }
                mx = fmaxf(mx, t);
            }
        mx = half_max(mx);
        float mn = mrun;
        if (__builtin_amdgcn_ballot_w64(mx > mrun + 8.f)) {
            mn = fmaxf(mrun, mx); const float alpha = __builtin_amdgcn_exp2f(mrun - mn); mrun = mn; lrun *= alpha;
#pragma unroll
            for (int db = 0; db < 2; ++db) O[db] *= alpha;
        }
        float ps = 0.f;
#pragma unroll
        for (int kb = 0; kb < 2; ++kb)
#pragma unroll
            for (int r = 0; r < 16; ++r) { const float t = S[kb][r];
                float pv = __builtin_amdgcn_exp2f(t - mn); if (TYPE != 2) pv = (t > -1e29f) ? pv : 0.f;
                S[kb][r] = pv; ps += pv; }
        lrun += ps;
        bf16x8 Pf[4];
#pragma unroll
        for (int kb = 0; kb < 2; ++kb)
#pragma unroll
            for (int m = 0; m < 2; ++m) { u32x4 w; w.x = cvt_pk_bf16(S[kb][8 * m], S[kb][8 * m + 1]); w.y = cvt_pk_bf16(S[kb][8 * m + 2], S[kb][8 * m + 3]);
                w.z = cvt_pk_bf16(S[kb][8 * m + 4], S[kb][8 * m + 5]); w.w = cvt_pk_bf16(S[kb][8 * m + 6], S[kb][8 * m + 7]); Pf[2 * kb + m] = __builtin_bit_cast(bf16x8, w); }
        u32x2 Vg[4][2];
#pragma unroll
        for (int ck = 0; ck < 4; ++ck) { const bf16_t* vp = Vt + (32 + l31) * VPI; const int sw = (4 + (l31 >> 3)) * 8; Vg[ck][0] = *(const u32x2*)(vp + ((ck * 16 + hi * 4) ^ sw)); Vg[ck][1] = *(const u32x2*)(vp + ((ck * 16 + 8 + hi * 4) ^ sw)); }
#pragma unroll
        for (int ck = 0; ck < 4; ++ck) { u32x4 w; w.x = Vf[ck][0].x; w.y = Vf[ck][0].y; w.z = Vf[ck][1].x; w.w = Vf[ck][1].y;
            O[0] = __builtin_amdgcn_mfma_f32_32x32x16_bf16(__builtin_bit_cast(bf16x8, w), Pf[ck], O[0], 0, 0, 0); }
#pragma unroll
        for (int ck = 0; ck < 4; ++ck) { u32x4 w; w.x = Vg[ck][0].x; w.y = Vg[ck][0].y; w.z = Vg[ck][1].x; w.w = Vg[ck][1].y;
            O[1] = __builtin_amdgcn_mfma_f32_32x32x16_bf16(__builtin_bit_cast(bf16x8, w), Pf[ck], O[1], 0, 0, 0); }
        }
        if (i + 1 < nt) ATT_WRITE((i + 1) & 1);
        __syncthreads();
        if (i + 2 < nt) ATT_PREFETCH(i + 2);
    }
#undef ATT_PREFETCH
#undef ATT_WRITE
    const int ycol = (TYPE == 0 ? 0 : (TYPE == 1 ? 512 : 1536)) + h * 64;
    const float inv = __builtin_amdgcn_rcpf(half_sum(lrun));
    bf16_t* yp = P.Y + (size_t)qrow * 2048 + ycol + hi * 4;
#pragma unroll
    for (int db = 0; db < 2; ++db)
#pragma unroll
        for (int rg = 0; rg < 4; ++rg) { u32x2 w; w.x = cvt_pk_bf16(O[db][4 * rg] * inv, O[db][4 * rg + 1] * inv); w.y = cvt_pk_bf16(O[db][4 * rg + 2] * inv, O[db][4 * rg + 3] * inv);
            *(u32x2*)(yp + db * 32 + rg * 8) = w; }
}
DEV void attn_phase(const int TID, unsigned char* lds, const AttnP& P, int nqt  ) {
    const int total = 3 * 512 + (nqt == 17 ? 96 : 0);
    const int vb = (gridDim.x % 8 == 0) ? (int)((blockIdx.x & 7) * (gridDim.x >> 3) + (blockIdx.x >> 3)) : (int)blockIdx.x;
    for (int it = vb; it < total; it += gridDim.x) {
        int type, b, h, qt;
        if (it < 1536) { type = 2 - (it >> 9); const int r = it & 511; qt = r & 15; h = (r >> 4) & 7; b = r >> 7; }
        else { const int r = it - 1536; type = 2 - r / 32; qt = 16; h = r & 7; b = (r >> 3) & 3; }
        if (type == 2) attn_item<2>(TID, lds, P, b, h, qt); else if (type == 1) attn_item<1>(TID, lds, P, b, h, qt); else attn_item<0>(TID, lds, P, b, h, qt);
    }
    __syncthreads();
}

DEV void mini_tile(const int TID, unsigned char* lds, const bf16_t* Ap, int lda, const bf16_t* Bp, int K, float (&v)[8], const int bstride = 16) {
    const int lane = TID & 63, wid = __builtin_amdgcn_readfirstlane(TID >> 6), fr = lane & 15, fq = lane >> 4;
    const int ksl = K >> 3, k0 = wid * ksl;
    f32x4 acc[4][4];
#pragma unroll
    for (int mb = 0; mb < 4; ++mb)
#pragma unroll
        for (int nb = 0; nb < 4; ++nb) acc[mb][nb] = (f32x4){0.f, 0.f, 0.f, 0.f};
    const bf16_t* ap = Ap + (size_t)fr * lda + k0 + fq * 8; const bf16_t* bp = Bp + (size_t)fr * K + k0 + fq * 8;
#pragma unroll 2
    for (int kk = 0; kk < ksl; kk += 32) {
        bf16x8 a[4], b[4];
#pragma unroll
        for (int i = 0; i < 4; ++i) { a[i] = *(const bf16x8*)(ap + (size_t)(i * 16) * lda + kk); b[i] = *(const bf16x8*)(bp + (size_t)(i * bstride) * K + kk); }
#pragma unroll
        for (int mb = 0; mb < 4; ++mb)
#pragma unroll
            for (int nb = 0; nb < 4; ++nb) acc[mb][nb] = __builtin_amdgcn_mfma_f32_16x16x32_bf16(a[mb], b[nb], acc[mb][nb], 0, 0, 0);
    }
    float* red = (float*)lds;
    __syncthreads();
#pragma unroll
    for (int mb = 0; mb < 4; ++mb)
#pragma unroll
        for (int nb = 0; nb < 4; ++nb)
#pragma unroll
            for (int j = 0; j < 4; ++j) red[wid * 4096 + (mb * 16 + fq * 4 + j) * 64 + nb * 16 + fr] = acc[mb][nb][j];
    __syncthreads();
    const float* rr = red + (TID >> 3) * 64 + (TID & 7) * 8;
    f32x4 s0 = *(const f32x4*)rr, s1 = *(const f32x4*)(rr + 4);
#pragma unroll
    for (int w = 1; w < 8; ++w) { s0 += *(const f32x4*)(rr + w * 4096); s1 += *(const f32x4*)(rr + w * 4096 + 4); }
    v[0] = s0[0]; v[1] = s0[1]; v[2] = s0[2]; v[3] = s0[3]; v[4] = s1[0]; v[5] = s1[1]; v[6] = s1[2]; v[7] = s1[3];
}
DEV void mini_resid(const int TID, unsigned char* lds, const bf16_t* A, int lda, const bf16_t* Bt, int K, const float* inc, float* outc, const float* gate, float s) {
    for (int it = blockIdx.x; it < 256; it += gridDim.x) {
        const int r0 = (it >> 4) * 64, c0 = (it & 15) * 64; float v[8];
        mini_tile(TID, lds, A + (size_t)(M_LAT + r0) * lda, lda, Bt + (size_t)c0 * K, K, v);
        const int row = r0 + (TID >> 3), col = c0 + (TID & 7) * 8; const size_t off = (size_t)row * D + col;
#pragma unroll
        for (int q = 0; q < 2; ++q) { const f32x4 g4 = *(const f32x4*)(gate + col + q * 4) * s, b4 = *(const f32x4*)(inc + off + q * 4);
            f32x4 a4; a4[0] = v[q * 4]; a4[1] = v[q * 4 + 1]; a4[2] = v[q * 4 + 2]; a4[3] = v[q * 4 + 3];
            *(f32x4*)(outc + off + q * 4) = b4 + g4 * a4; }
    }
    __syncthreads();
}
DEV void mini_pgemm(const int TID, unsigned char* lds, const bf16_t* Yb, const bf16_t* Wbr, bf16_t* PBo) {
    for (int it = blockIdx.x; it < 1024; it += gridDim.x) {
        const int r0 = (it >> 6) * 64, c0 = (it & 63) * 64; float v[8];
        mini_tile(TID, lds, Yb + (size_t)(M_LAT + r0) * 2048 + (c0 >> 10) * 512, 2048, Wbr + (size_t)c0 * 512, 512, v);
        const int row = M_LAT + r0 + (TID >> 3), col = c0 + (TID & 7) * 8;
        u32x4 w; w.x = cvt_pk_bf16(v[0], v[1]); w.y = cvt_pk_bf16(v[2], v[3]); w.z = cvt_pk_bf16(v[4], v[5]); w.w = cvt_pk_bf16(v[6], v[7]);
        *(u32x4*)(PBo + (size_t)row * 4096 + col) = w;
    }
    __syncthreads();
}
DEV void mini_merge(const int TID, unsigned char* lds, const bf16_t* XNb, const bf16_t* Wg, const bf16_t* PBi, bf16_t* MBo) {
    for (int it = blockIdx.x; it < 256; it += gridDim.x) {
        const int r0 = (it >> 4) * 64, c0 = (it & 15) * 64;
        const int row = M_LAT + r0 + (TID >> 3), col = c0 + (TID & 7) * 8;
        float R[8];
#pragma unroll
        for (int j = 0; j < 8; ++j) R[j] = 0.f;
#pragma unroll 1
        for (int n = 0; n < 4; ++n) {
            const int bro = (c0 >> 6) * 256 + (n >> 1) * 128 + (n & 1) * 16; float v[8];
            mini_tile(TID, lds, XNb + (size_t)(M_LAT + r0) * D, D, Wg + (size_t)bro * D, D, v, 32);
            const u32x4 pw = *(const u32x4*)(PBi + (size_t)row * 4096 + n * 1024 + col);
            R[0] += bflo(pw.x) * sigmoidf_(v[0]); R[1] += bfhi(pw.x) * sigmoidf_(v[1]); R[2] += bflo(pw.y) * sigmoidf_(v[2]); R[3] += bfhi(pw.y) * sigmoidf_(v[3]);
            R[4] += bflo(pw.z) * sigmoidf_(v[4]); R[5] += bfhi(pw.z) * sigmoidf_(v[5]); R[6] += bflo(pw.w) * sigmoidf_(v[6]); R[7] += bfhi(pw.w) * sigmoidf_(v[7]);
        }
        u32x4 w; w.x = cvt_pk_bf16(R[0], R[1]); w.y = cvt_pk_bf16(R[2], R[3]); w.z = cvt_pk_bf16(R[4], R[5]); w.w = cvt_pk_bf16(R[6], R[7]);
        *(u32x4*)(MBo + (size_t)row * D + col) = w;
    }
    __syncthreads();
}

#define LAS __attribute__((address_space(3)))
#define XB_TMO      128
#define XB_XCNT(j)  (256  + 64 * (j))
#define XB_XSUB(j)  (1280 + 64 * (j))
#define XB_XGEN(j)  (2304 + 64 * (j))
#define XB_TOP      3328
#define XB_TOPGEN   3392
#define XCD_BAR_WORDS 3456
#define XB_SPIN_CAP (1u << 18)

__device__ __forceinline__ unsigned xb_ld(unsigned* p)              { return __hip_atomic_load(p, __ATOMIC_RELAXED, __HIP_MEMORY_SCOPE_AGENT); }
__device__ __forceinline__ unsigned xb_add(unsigned* p, unsigned v) { return __hip_atomic_fetch_add(p, v, __ATOMIC_RELAXED, __HIP_MEMORY_SCOPE_AGENT); }
__device__ __forceinline__ unsigned xb_xcc_id() { return (unsigned)__builtin_amdgcn_s_getreg((3 << 11) | 20) & 0xFu; }
#define XB_SPIN(cond, bar) do { unsigned _sp = 0; while (cond) { __builtin_amdgcn_s_sleep(1); \
    if ((++_sp & 255u) == 0u) { if (xb_ld(&(bar)[XB_TMO])) break; if (_sp > XB_SPIN_CAP) { atomicAdd(&(bar)[XB_TMO], 1u); break; } } } } while (0)

struct XcdBarrier {
    unsigned* bar; unsigned x;
    volatile LAS unsigned* st;
};

__device__ __forceinline__ XcdBarrier xcd_barrier_post(unsigned* bar, volatile LAS unsigned* st) {
    XcdBarrier b; b.bar = bar; b.x = xb_xcc_id(); b.st = st;
    if (threadIdx.x == 0) (void)xb_add(&bar[XB_XCNT(b.x)], 1u);
    return b;
}
__device__ __forceinline__ void xcd_barrier_complete(unsigned* bar, unsigned x, unsigned& nloc, unsigned& nx) {
    const unsigned G = gridDim.x * gridDim.y * gridDim.z;
    unsigned sum, cnt, mine, sp = 0u;
    for (;;) {
        sum = 0u; cnt = 0u; mine = 0u;
#pragma unroll
        for (unsigned j = 0; j < 16; ++j) { const unsigned c = xb_ld(&bar[XB_XCNT(j)]); sum += c; cnt += (c > 0u) ? 1u : 0u; mine = (j == x) ? c : mine; }
        if (sum == G) break;
        __builtin_amdgcn_s_sleep(1);
        if ((++sp & 255u) == 0u) { if (xb_ld(&bar[XB_TMO])) break; if (sp > XB_SPIN_CAP) { atomicAdd(&bar[XB_TMO], 1u); break; } }
    }
    nloc = mine > 0u ? mine : 1u; nx = cnt > 0u ? cnt : 1u;
}

__device__ __forceinline__ void xcd_barrier(const XcdBarrier& b) {
    asm volatile("s_waitcnt vmcnt(0)" ::: "memory");
    __syncthreads();
    if (threadIdx.x == 0) {
        unsigned* bar = b.bar;
        __builtin_amdgcn_s_waitcnt(0);
        unsigned nloc = b.st[0], nx = b.st[1];
        if (nloc == 0u) { xcd_barrier_complete(bar, b.x, nloc, nx); b.st[0] = nloc; b.st[1] = nx; }
        const unsigned old = xb_add(&bar[XB_XSUB(b.x)], 1u);
        const unsigned gen = old / nloc;
        if (old + 1u == (gen + 1u) * nloc) {
            __builtin_amdgcn_fence(__ATOMIC_RELEASE, "agent");
            asm volatile("s_waitcnt vmcnt(0)" ::: "memory");
            const unsigned og = xb_add(&bar[XB_TOP], 1u);
            const unsigned tg = og / nx;
            if (og + 1u == (tg + 1u) * nx) xb_add(&bar[XB_TOPGEN], 1u);
            else XB_SPIN(xb_ld(&bar[XB_TOPGEN]) == tg, bar);
            __builtin_amdgcn_fence(__ATOMIC_ACQUIRE, "agent");
            xb_add(&bar[XB_XGEN(b.x)], 1u);
            asm volatile("s_waitcnt vmcnt(0)" ::: "memory");
        } else {
            XB_SPIN(xb_ld(&bar[XB_XGEN(b.x)]) == gen, bar);
            __builtin_amdgcn_fence(__ATOMIC_ACQUIRE, "agent");
            asm volatile("s_waitcnt vmcnt(0)" ::: "memory");
        }
    }
    __syncthreads();
}

#ifndef PHMASK
#define PHMASK 0xffffffffu
#endif
constexpr int PER_LAYER = 15;
constexpr int N_PHASES = 1 + 2 * PER_LAYER + 1;
__global__ void __launch_bounds__(NTHREADS, 2) fwd_kernel(KP pbyval) {
    extern __shared__ __attribute__((aligned(16))) unsigned char lds[];
    cg::grid_group grid = cg::this_grid();
    KPP p = (KPP)__builtin_amdgcn_kernarg_segment_ptr();
    const int ph_lo = p->ph_lo, ph_hi = p->ph_hi;
    const int wid_s = __builtin_amdgcn_readfirstlane((int)(threadIdx.x >> 6));
    volatile LAS unsigned* bst = (volatile LAS unsigned*)((LAS unsigned char*)lds + (LDS_BYTES - 64));
    if (threadIdx.x < 2) bst[threadIdx.x] = 0u;
    __syncthreads();
    const XcdBarrier xbar = xcd_barrier_post((unsigned*)(p->ws + WS_CTL), bst);
#pragma unroll 1
    for (int ph = ph_lo; ph < ph_hi; ++ph) {
        asm volatile("" : "+s"(p));
        unsigned allm = ~0u; asm volatile("" : "+s"(allm));
        int TID = (wid_s << 6) | (int)__builtin_amdgcn_mbcnt_hi(allm, __builtin_amdgcn_mbcnt_lo(allm, 0u)); asm volatile("" : "+v"(TID));
        int kind, l;
        if (ph < 1) { kind = 0; l = 0; } else if (ph == N_PHASES - 1) { kind = 18; l = 0; } else { l = (ph - 1) / PER_LAYER; kind = 2 + (ph - 1) % PER_LAYER; if (kind >= 9) kind += 1; }
        PG8_LAS unsigned char* ldsl = (PG8_LAS unsigned char*)lds;
        const int G = gridDim.x, cb = blockIdx.x;
        const bool last = (l == 1);
        const int Mpost = last ? M_LAT : M_ALL;
#define MOD ((float*)(p->ws + WS_MOD))
#define HC ((float*)(p->ws + WS_HC))
#define XN ((bf16_t*)(p->ws + WS_XN))
#define Y ((bf16_t*)(p->ws + WS_Y))
#define G5 ((bf16_t*)(p->ws + WS_G5))
#define WA ((bf16_t*)(p->ws + WS_BIG + BIG_WA))
#define MLAQ ((bf16_t*)(p->ws + WS_BIG + BIG_MLAQ))
#define MLAKV ((bf16_t*)(p->ws + WS_BIG + BIG_MLAKV))
#define ACT ((bf16_t*)(p->ws + WS_BIG))
#define PB ((bf16_t*)(p->ws + WS_BIG + BIG_P))
#define MB ((bf16_t*)(p->ws + WS_BIG + BIG_MB))
#define wb (p->ws + WS_WB)
#define modl (MOD + (size_t)l * 5 * 9 * 1024)
#define KIND(k) (((PHMASK >> (k)) & 1u) && kind == (k))
        if (KIND(0)) { modp_phase(TID, p, lds); wprep_phase(TID, p, lds, 0, 0); }
        else if (KIND(2)) { const float* hlat = (l == 0) ? p->in[0] : p->out; const float* hctx = (l == 0) ? p->in[2] : HC;
            norm_phase(TID, p, hlat, hctx, p->in[6] + l * D, modl, 0, M_ALL); if (l == 1) wprep_phase(TID, p, lds, 1, 0); }
        else if (KIND(3)) { pg8::Gemm g{XN, D, (const bf16_t*)(wb + WB_GU), M_ALL, 5632, D, 0, 0}; pg8::StaticOrder S; S.init(M_ALL, 5632, G, cb); EpiSwiglu E{ACT};
            pg8::gemm_phase<EpiSwiglu, pg8::StaticOrder, true, true>(TID, ldsl, g, S, E); }
        else if (KIND(4)) { const float* hlat = (l == 0) ? p->in[0] : p->out; const float* hctx = (l == 0) ? p->in[2] : HC;
            pg8::Gemm g{ACT, DFF, (const bf16_t*)(wb + WB_DN), M_LAT, D, DFF, 0, 0}; pg8::StaticOrder S; S.init(M_LAT, D, G, cb);
            EpiResid E{hlat, hctx, p->out, HC, modl + 2 * 1024, 0.5f};
            pg8::gemm_phase<EpiResid, pg8::StaticOrder, true, true>(TID, ldsl, g, S, E);
            mini_resid(TID, lds, ACT, DFF, (const bf16_t*)(wb + WB_DN), DFF, hctx, HC, modl + (size_t)(4 * 9 + 2) * 1024, 0.5f); }
        else if (KIND(5)) { norm_phase(TID, p, p->out, HC, p->in[10] + l * D, modl, 3, M_ALL); }
        else if (KIND(6)) { pg8::Gemm g{XN, D, (const bf16_t*)(wb + WB_INA), M_ALL, WA_N, D, 0, 0}; pg8::StaticOrder S; S.init(M_ALL, WA_N, G, cb); EpiStore E{WA, WA_N};
            pg8::gemm_phase<EpiStore, pg8::StaticOrder, true, true>(TID, ldsl, g, S, E);
            S5L L5{p->in[14] + l * 4096, p->in[15] + l * 4096, p->in[16] + l * 64, p->in[17] + (size_t)l * 65536, p->in[18] + (size_t)l * 65536,
                   p->in[19] + (size_t)l * 65536, p->in[20] + (size_t)l * 65536, p->in[21] + l * 512};
            const int nfull = (M_ALL / 256) * (WA_N / 256) - 3 * G;
            if (nfull > 0 && nfull < G) s5_pre_phase(TID, p, L5, lds, nfull, G - nfull); else s5_pre_phase(TID, p, L5, lds, 0, G); }
        else if (KIND(7) || KIND(8) || KIND(10)) {
            S5L L5{p->in[14] + l * 4096, p->in[15] + l * 4096, p->in[16] + l * 64, p->in[17] + (size_t)l * 65536, p->in[18] + (size_t)l * 65536,
                   p->in[19] + (size_t)l * 65536, p->in[20] + (size_t)l * 65536, p->in[21] + l * 512};
            if (kind == 7) { mlanorm_phase(TID, p, p->in[24] + l * 256, p->in[26] + l * 128); s5_local_phase(TID, p, L5); }
            else if (kind == 8) { s5_carry_phase(TID, p, L5);
                pg8::Gemm g{WA + C_CQ, WA_N, (const bf16_t*)(wb + WB_UQ), M_ALL, 768, 256, 0, 0}; pg8::StaticOrder S; S.init(M_ALL, 768, G, cb); EpiStore E{MLAQ, 768};
                pg8::gemm_phase<EpiStore, pg8::StaticOrder, true, true>(TID, ldsl, g, S, E);
                pg8::Gemm g2{WA + C_CKV, WA_N, (const bf16_t*)(wb + WB_UKV), M_ALL, 1024, 128, 0, 0}; pg8::StaticOrder S2; S2.init(M_ALL, 1024, G, cb); EpiStore E2{MLAKV, 1024};
                pg8::gemm_phase<EpiStore, pg8::StaticOrder, true, true>(TID, ldsl, g2, S2, E2); }
            else { AttnP AP{WA, MLAQ, MLAKV, Y, p->in[12] + l * 3720, p->in[13] + l * 8}; attn_phase(TID, lds, AP, last ? 16 : 17);
                s5_out_phase(TID, p, L5, last); }
        }
        else if (KIND(11)) { pg8::Gemm g{G5, 512, (const bf16_t*)(wb + WB_GLU), Mpost, 512, 512, 0, 0}; pg8::StaticOrder S; S.init(Mpost, 512, G, cb); EpiGlu E{G5, p->in[23] + l * 512, Y};
            pg8::gemm_phase<EpiGlu, pg8::StaticOrder, true, true>(TID, ldsl, g, S, E); wprep_phase(TID, p, lds, l, 1); }
        else if (KIND(12)) { pg8::Gemm g{Y, 2048, (const bf16_t*)(wb + WB_BR), M_LAT, 4096, 512, 4, 512}; pg8::StaticOrder S; S.init(M_LAT, 4096, G, cb); EpiStore E{PB, 4096};
            pg8::gemm_phase<EpiStore, pg8::StaticOrder, true, true>(TID, ldsl, g, S, E);
            if (!last) mini_pgemm(TID, lds, Y, (const bf16_t*)(wb + WB_BR), PB); }
        else if (KIND(13)) { pg8::Gemm g{XN, D, (const bf16_t*)(wb + WB_G), M_LAT, 4096, D, 0, 0}; pg8::StaticOrder S; S.init(M_LAT, 4096, G, cb); EpiMerge E{PB, MB};
            pg8::gemm_phase<EpiMerge, pg8::StaticOrder, true, true>(TID, ldsl, g, S, E);
            if (!last) mini_merge(TID, lds, XN, (const bf16_t*)(wb + WB_G), PB, MB); }
        else if (KIND(14)) { pg8::Gemm g{MB, D, (const bf16_t*)(wb + WB_OUT), M_LAT, D, D, 0, 0}; pg8::StaticOrder S; S.init(M_LAT, D, G, cb);
            EpiResid E{p->out, HC, p->out, HC, modl + 5 * 1024, 1.0f};
            pg8::gemm_phase<EpiResid, pg8::StaticOrder, true, true>(TID, ldsl, g, S, E);
            if (!last) mini_resid(TID, lds, MB, D, (const bf16_t*)(wb + WB_OUT), D, HC, HC, modl + (size_t)(4 * 9 + 5) * 1024, 1.0f); }
        else if (KIND(15)) { norm_phase(TID, p, p->out, HC, p->in[30] + l * D, modl, 6, Mpost); }
        else if (KIND(16)) { pg8::Gemm g{XN, D, (const bf16_t*)(wb + WB_GU), Mpost, 5632, D, 0, 0}; pg8::StaticOrder S; S.init(Mpost, 5632, G, cb); EpiSwiglu E{ACT};
            pg8::gemm_phase<EpiSwiglu, pg8::StaticOrder, true, true>(TID, ldsl, g, S, E); }
        else if (KIND(17)) { pg8::Gemm g{ACT, DFF, (const bf16_t*)(wb + WB_DN), M_LAT, D, DFF, 0, 0}; pg8::StaticOrder S; S.init(M_LAT, D, G, cb);
            EpiResid E{p->out, HC, p->out, HC, modl + 8 * 1024, 0.5f};
            pg8::gemm_phase<EpiResid, pg8::StaticOrder, true, true>(TID, ldsl, g, S, E);
            if (!last) mini_resid(TID, lds, ACT, DFF, (const bf16_t*)(wb + WB_DN), DFF, HC, HC, modl + (size_t)(4 * 9 + 8) * 1024, 0.5f); }
        else if (KIND(18)) { final_phase(TID, p); }
#undef KIND
#undef MOD
#undef HC
#undef XN
#undef Y
#undef G5
#undef WA
#undef MLAQ
#undef MLAKV
#undef ACT
#undef PB
#undef MB
#undef wb
#undef modl
        if (ph + 1 < ph_hi) { if (ph_lo < 0) grid.sync(); else xcd_barrier(xbar); }
    }
}

extern "C" void kernel_launch(void* const* d_in, const int* in_sizes, int n_in, void* d_out, int out_size, void* d_ws, size_t ws_size, hipStream_t stream) {
    static int grid = 0;
    if (grid == 0) {
        if (n_in != 35 || out_size != M_LAT * D || ws_size < WS_END) { fprintf(stderr, "kernel_launch: unexpected shapes (n_in %d out %d ws %zu need %zu)\n", n_in, out_size, ws_size, (size_t)WS_END); grid = -1; return; }
        int dev = 0, cus = 0, per_cu = 0;
        hipGetDevice(&dev); hipDeviceGetAttribute(&cus, hipDeviceAttributeMultiprocessorCount, dev);
        if (hipFuncSetAttribute((const void*)fwd_kernel, hipFuncAttributeMaxDynamicSharedMemorySize, LDS_BYTES) != hipSuccess) { fprintf(stderr, "kernel_launch: hipFuncSetAttribute failed\n"); grid = -1; return; }
        if (hipOccupancyMaxActiveBlocksPerMultiprocessor(&per_cu, (const void*)fwd_kernel, NTHREADS, LDS_BYTES) != hipSuccess || per_cu < 1) { fprintf(stderr, "kernel_launch: occupancy query failed (%d)\n", per_cu); (void)hipGetLastError(); per_cu = 1; }
        grid = cus * 1;
        if (grid < 8) grid = 8;
    }
    if (grid < 0) return;
    if (hipMemsetAsync((char*)d_ws, 0, WS_CTL + CTL_BYTES, stream) != hipSuccess) { fprintf(stderr, "kernel_launch: memset failed\n"); return; }
    KP a{};
    for (int i = 0; i < 35; ++i) a.in[i] = (const float*)d_in[i];
    a.out = (float*)d_out; a.ws = (unsigned char*)d_ws; a.ph_lo = 0; a.ph_hi = N_PHASES;
    void* args[] = {&a};
    hipError_t e = hipLaunchCooperativeKernel((const void*)fwd_kernel, dim3(grid), dim3(NTHREADS), args, LDS_BYTES, stream);
    if (e != hipSuccess) fprintf(stderr, "cooperative launch failed: %s (grid %d)\n", hipGetErrorString(e), grid);
}
```

```cpp
#include <hip/hip_runtime.h>
#include <hip/hip_cooperative_groups.h>
#include <cstdio>
#include <cstdint>
namespace cg = cooperative_groups;

namespace pg8 {
#define PG8_LAS __attribute__((address_space(3)))
typedef unsigned short bf16_t;
typedef short bf16x8 __attribute__((ext_vector_type(8)));
typedef short s16x4 __attribute__((ext_vector_type(4)));
typedef float f32x4 __attribute__((ext_vector_type(4)));
typedef unsigned u32x4 __attribute__((ext_vector_type(4)));
typedef unsigned u32x2 __attribute__((ext_vector_type(2)));
constexpr int BM = 256, BK = 64, HALF = 128, HTB = HALF * BK * 2, STAGE_BYTES = 8 * HTB, NXCD = 8, WGM = 8;

__host__ __device__ __forceinline__ int lds_byte(int r, int c) { const int st = (r >> 4) * 2 + (c >> 5), rr = r & 15, cc = c & 31, ob = rr * 64 + cc * 2; return st * 1024 + (ob ^ (((ob >> 9) & 1) << 5)); }
__host__ __device__ __forceinline__ void stage_rc(int b, int& R, int& C) { const int st = b / 1024, sb = b % 1024, swz = sb ^ (((sb >> 9) & 1) << 5); R = (st >> 1) * 16 + swz / 64; C = (st & 1) * 32 + (swz % 64) / 2; }

__host__ __device__ __forceinline__ int perm32(int rho) { const int n = rho >> 4, i = rho & 15; return 8 * (i >> 2) + 4 * n + (i & 3); }
struct Unit { int pm, pn; };
struct Gemm { const bf16_t* A; int lda; const bf16_t* Bt; int M, N, K; int a_div; int a_stride; };

struct StaticOrder {
    int nM, nN, nwg, G, c;
    __host__ __device__ void init(int M, int N, int G_, int c_) { nM = M / BM; nN = N / BM; nwg = nM * nN; G = G_; c = c_; }
    __host__ __device__ bool next(int i, Unit& u) const {
        const long L = (long)i * G + c; if (L >= nwg) return false;
        int wgid = (int)L; { const int q = nwg / NXCD, r = nwg % NXCD, xcd = wgid % NXCD, off = wgid / NXCD; wgid = (xcd < r ? xcd * (q + 1) : r * (q + 1) + (xcd - r) * q) + off; }
        const int nig = WGM * nN, gid = wgid / nig, fm = gid * WGM, gsz = (nM - fm) < WGM ? (nM - fm) : WGM;
        u.pm = fm + ((wgid % nig) % gsz); u.pn = (wgid % nig) / gsz; return true;
    }
};
__device__ __forceinline__ unsigned cvt_pk_bf16(float lo, float hi) { unsigned r; asm volatile("v_cvt_pk_bf16_f32 %0, %1, %2" : "=v"(r) : "v"(lo), "v"(hi)); return r; }

template <class Epi, class Sched, bool ALIGN_EPI = false, bool SP2 = false>
__device__ __forceinline__ void gemm_phase(const int TID, PG8_LAS unsigned char* lds, const Gemm g, const Sched& S, const Epi& E) {
    const int tid = TID, wid = __builtin_amdgcn_readfirstlane(tid >> 6), lane = tid & 63, wr = wid >> 2, wc = wid & 3, fr = lane & 15, fq = lane >> 4;
    int K = g.K, lda = g.lda; asm volatile("" : "+s"(K), "+s"(lda));
    const int nt = K / BK;
    unsigned voffA[2], voffB[2];
#pragma unroll
    for (int i = 0; i < 2; ++i) { int R, C; stage_rc(tid * 16 + i * 8192, R, C);
        const int Rb = Epi::PERM ? ((R & ~31) + perm32(R & 31)) : R;
        voffA[i] = (unsigned)(R * lda + C) * 2u; voffB[i] = (unsigned)(Rb * K + C) * 2u; }
    const size_t kstep = (size_t)(BK * 2);
    const size_t hstepA = (size_t)HALF * lda * 2, hstepB = (size_t)HALF * K * 2;
    const size_t tstepA = 2 * hstepA, tstepB = 2 * hstepB;
    const unsigned ldsw = (unsigned)wid * 1024u;
    const int aoff = lds_byte(wr * 64 + fr, fq * 8), boff = lds_byte(wc * 32 + fr, fq * 8);
#define PG8_ABASE(u) ((const char*)g.A + (size_t)(u).pm * tstepA + (g.a_div ? (size_t)((u).pn / g.a_div) * (size_t)g.a_stride * 2 : (size_t)0))
#define PG8_SA(b, h) (((b) * 2 + (h)) * HTB)
#define PG8_SB(b, h) ((4 + (b) * 2 + (h)) * HTB)
#define PG8_STAGE(bufoff, gbase, voff) do { _Pragma("unroll") for (int _i = 0; _i < 2; ++_i) \
        __builtin_amdgcn_global_load_lds((const unsigned*)((const char*)(gbase) + (voff)[_i]), (PG8_LAS unsigned*)(lds + (bufoff) + ldsw + _i * 8192), 16, 0, 0); } while (0)
#define PG8_LDA(dst, b, h) do { _Pragma("unroll") for (int m = 0; m < 4; ++m) _Pragma("unroll") for (int k = 0; k < 2; ++k) dst[m][k] = *(const PG8_LAS bf16x8*)(lds + PG8_SA(b, h) + aoff + m * 2048 + k * 1024); } while (0)
#define PG8_LDB(dst, b, h) do { _Pragma("unroll") for (int n = 0; n < 2; ++n) _Pragma("unroll") for (int k = 0; k < 2; ++k) dst[n][k] = *(const PG8_LAS bf16x8*)(lds + PG8_SB(b, h) + boff + n * 2048 + k * 1024); } while (0)
#define PG8_MMA(ai, bj, At, Bt) do { __builtin_amdgcn_s_setprio(1); _Pragma("unroll") for (int m = 0; m < 4; ++m) _Pragma("unroll") for (int n = 0; n < 2; ++n) _Pragma("unroll") for (int k = 0; k < 2; ++k) \
        acc[ai][bj][m][n] = __builtin_amdgcn_mfma_f32_16x16x32_bf16(Bt[n][k], At[m][k], acc[ai][bj][m][n], 0, 0, 0); __builtin_amdgcn_s_setprio(0); } while (0)
#define PG8_WAIT_V(n) asm volatile("s_waitcnt vmcnt(" #n ")" ::: "memory")
#define PG8_WAIT_L(n) asm volatile("s_waitcnt lgkmcnt(" #n ")" ::: "memory")
#define PG8_BAR __builtin_amdgcn_s_barrier()
#define PG8_SCHED __builtin_amdgcn_sched_barrier(0)
    Unit cur, nxt; int ui = 0;
    if (!S.next(0, cur)) return;
    f32x4 acc[2][2][4][2];
#pragma unroll
    for (int a = 0; a < 2; ++a)
#pragma unroll
        for (int b = 0; b < 2; ++b)
#pragma unroll
            for (int m = 0; m < 4; ++m)
#pragma unroll
                for (int n = 0; n < 2; ++n) acc[a][b][m][n] = (f32x4){0.f, 0.f, 0.f, 0.f};
    bf16x8 At[4][2], B0[2][2], B1[2][2];
    const char* cA = PG8_ABASE(cur); const char* cB = (const char*)g.Bt + (size_t)cur.pn * tstepB;
    if constexpr (SP2) {
        PG8_STAGE(PG8_SB(0, 0), cB, voffB); PG8_STAGE(PG8_SB(0, 1), cB + hstepB, voffB); PG8_STAGE(PG8_SA(0, 0), cA, voffA); PG8_STAGE(PG8_SA(0, 1), cA + hstepA, voffA);
        if (wr == 1) PG8_BAR;
        PG8_WAIT_V(2); PG8_BAR;
        PG8_STAGE(PG8_SB(1, 0), cB + kstep, voffB); PG8_STAGE(PG8_SA(1, 0), cA + kstep, voffA); PG8_STAGE(PG8_SB(1, 1), cB + hstepB + kstep, voffB);
        PG8_WAIT_V(6); PG8_BAR;
    } else {
        PG8_STAGE(PG8_SB(0, 0), cB, voffB); PG8_STAGE(PG8_SA(0, 0), cA, voffA); PG8_STAGE(PG8_SB(0, 1), cB + hstepB, voffB); PG8_STAGE(PG8_SA(0, 1), cA + hstepA, voffA);
        if (wr == 1) PG8_BAR;
        PG8_WAIT_V(4); PG8_BAR;
        PG8_STAGE(PG8_SB(1, 0), cB + kstep, voffB); PG8_STAGE(PG8_SA(1, 0), cA + kstep, voffA); PG8_STAGE(PG8_SB(1, 1), cB + hstepB + kstep, voffB);
        PG8_WAIT_V(6); PG8_BAR;
    }
    for (;;) {
        const bool has_next = S.next(ui + 1, nxt);
        const char* nA = has_next ? PG8_ABASE(nxt) : cA; const char* nB = has_next ? (const char*)g.Bt + (size_t)nxt.pn * tstepB : cB;
        for (int t = 0; t < nt; t += 2) {
            const bool last = (t == nt - 2);
            const char* a1 = cA + (size_t)(t + 1) * kstep;
            const char* a2 = last ? nA : cA + (size_t)(t + 2) * kstep; const char* b2 = last ? nB : cB + (size_t)(t + 2) * kstep;
            const char* a3 = a2 + kstep; const char* b3 = b2 + kstep;
            if constexpr (SP2) {
            PG8_LDB(B0, 0, 0); PG8_LDB(B1, 0, 1); PG8_SCHED; PG8_LDA(At, 0, 0); PG8_STAGE(PG8_SA(1, 1), a1 + hstepA, voffA);
            PG8_WAIT_V(8); PG8_WAIT_L(0); PG8_BAR; PG8_MMA(0, 0, At, B0); PG8_MMA(0, 1, At, B1); PG8_BAR; PG8_SCHED;
            PG8_LDA(At, 0, 1); PG8_STAGE(PG8_SB(0, 0), b2, voffB); PG8_STAGE(PG8_SB(0, 1), b2 + hstepB, voffB); PG8_STAGE(PG8_SA(0, 0), a2, voffA);
            PG8_WAIT_V(8); PG8_WAIT_L(0); PG8_BAR; PG8_MMA(1, 0, At, B0); PG8_MMA(1, 1, At, B1); PG8_BAR; PG8_SCHED;
            PG8_LDB(B0, 1, 0); PG8_LDB(B1, 1, 1); PG8_SCHED; PG8_LDA(At, 1, 0); PG8_STAGE(PG8_SA(0, 1), a2 + hstepA, voffA);
            PG8_WAIT_V(8); PG8_WAIT_L(0); PG8_BAR; PG8_MMA(0, 0, At, B0); PG8_MMA(0, 1, At, B1); PG8_BAR; PG8_SCHED;
            PG8_LDA(At, 1, 1); PG8_STAGE(PG8_SB(1, 0), b3, voffB); PG8_STAGE(PG8_SB(1, 1), b3 + hstepB, voffB); PG8_STAGE(PG8_SA(1, 0), a3, voffA);
            PG8_WAIT_V(8); PG8_WAIT_L(0); PG8_BAR; PG8_MMA(1, 0, At, B0); PG8_MMA(1, 1, At, B1); PG8_BAR; PG8_SCHED;
            } else {
            PG8_LDB(B0, 0, 0); PG8_SCHED; PG8_LDA(At, 0, 0); PG8_STAGE(PG8_SA(1, 1), a1 + hstepA, voffA);
            PG8_WAIT_L(8); PG8_BAR; PG8_WAIT_L(0); PG8_MMA(0, 0, At, B0); PG8_BAR; PG8_SCHED;
            PG8_LDB(B1, 0, 1); PG8_STAGE(PG8_SB(0, 0), b2, voffB);
            PG8_BAR; PG8_WAIT_L(0); PG8_MMA(0, 1, At, B1); PG8_BAR;
            PG8_LDA(At, 0, 1); PG8_STAGE(PG8_SA(0, 0), a2, voffA);
            PG8_BAR; PG8_WAIT_L(0); PG8_MMA(1, 0, At, B0); PG8_BAR; PG8_SCHED;
            PG8_STAGE(PG8_SB(0, 1), b2 + hstepB, voffB);
            PG8_WAIT_V(6); PG8_BAR; PG8_MMA(1, 1, At, B1); PG8_BAR;
            PG8_LDB(B0, 1, 0); PG8_SCHED; PG8_LDA(At, 1, 0); PG8_STAGE(PG8_SA(0, 1), a2 + hstepA, voffA);
            PG8_WAIT_L(8); PG8_BAR; PG8_WAIT_L(0); PG8_MMA(0, 0, At, B0); PG8_BAR; PG8_SCHED;
            PG8_LDB(B1, 1, 1); PG8_STAGE(PG8_SB(1, 0), b3, voffB);
            PG8_BAR; PG8_WAIT_L(0); PG8_MMA(0, 1, At, B1); PG8_BAR;
            PG8_LDA(At, 1, 1); PG8_STAGE(PG8_SA(1, 0), a3, voffA);
            PG8_BAR; PG8_WAIT_L(0); PG8_MMA(1, 0, At, B0); PG8_BAR; PG8_SCHED;
            PG8_STAGE(PG8_SB(1, 1), b3 + hstepB, voffB);
            PG8_WAIT_V(6); PG8_BAR; PG8_MMA(1, 1, At, B1); PG8_BAR;
            }
        }
        if constexpr (ALIGN_EPI) { if (wr == 0) PG8_BAR; }
        E(acc, cur, wr, wc, fr, fq);
        if (!has_next) break;
#pragma unroll
        for (int a = 0; a < 2; ++a)
#pragma unroll
            for (int b = 0; b < 2; ++b)
#pragma unroll
                for (int m = 0; m < 4; ++m)
#pragma unroll
                    for (int n = 0; n < 2; ++n) acc[a][b][m][n] = (f32x4){0.f, 0.f, 0.f, 0.f};
        cur = nxt; cA = nA; cB = nB; ++ui;
        if constexpr (ALIGN_EPI) { if (wr == 1) PG8_BAR; }
    }
    PG8_WAIT_V(0);
    if constexpr (!ALIGN_EPI) { if (wr == 0) PG8_BAR; }
    PG8_BAR;
#undef PG8_ABASE
#undef PG8_SA
#undef PG8_SB
#undef PG8_STAGE
#undef PG8_LDA
#undef PG8_LDB
#undef PG8_MMA
#undef PG8_WAIT_V
#undef PG8_WAIT_L
#undef PG8_BAR
#undef PG8_SCHED
}
}

using pg8::bf16_t; using pg8::bf16x8; using pg8::s16x4; using pg8::f32x4; using pg8::u32x4; using pg8::u32x2; using pg8::cvt_pk_bf16; using pg8::Unit;

constexpr int D = 1024, BATCH = 4, SEQ = 4096, CTX = 256, DFF = 2816, NMOD = 9;
constexpr int M_LAT = BATCH * SEQ, M_ALL = M_LAT + BATCH * CTX;
constexpr int WA_N = 3328, INCOLS = 7328;
constexpr int C_NAQ = 0, C_NAK = 512, C_NAV = 1024, C_SWQ = 1536, C_SWK = 2048, C_SWV = 2176, C_S5U = 2304, C_CQ = 2816, C_CKV = 3072, C_KR = 3200;
constexpr float EPS = 1e-6f, LOG2E = 1.4426950408889634f;
constexpr int NTHREADS = 512, NWAVES = 8;
constexpr int LDS_BYTES = 147456;

constexpr size_t MiB = 1u << 20;
constexpr size_t WS_MOD = 0;
constexpr size_t WS_CTL = 512 * 1024, CTL_BYTES = 16384;
constexpr size_t WS_HC = 1 * MiB;
constexpr size_t WS_S5 = 5 * MiB;
constexpr size_t WS_WB = 14 * MiB;
constexpr size_t WB_GU = 0, WB_DN = 11 * MiB, WB_INA = WB_DN + 5632 * 1024, WB_G = WB_INA + 6656 * 1024, WB_UQ = WB_G + 8 * MiB,
                 WB_UKV = WB_UQ + 384 * 1024, WB_BR = WB_UKV + 256 * 1024, WB_OUT = WB_BR + 4 * MiB, WB_GLU = WB_OUT + 2 * MiB, WB_END = WB_GLU + 512 * 1024;
static_assert(WB_END <= 39 * MiB, "weights");
constexpr size_t WS_G5 = 53 * MiB;
constexpr size_t WS_XN = 70 * MiB;
constexpr size_t WS_Y = 104 * MiB;
constexpr size_t WS_BIG = 172 * MiB;
constexpr size_t BIG_WA = 0, BIG_MLAQ = (size_t)M_ALL * WA_N * 2, BIG_MLAKV = BIG_MLAQ + (size_t)M_ALL * 768 * 2, BIG_END = BIG_MLAKV + (size_t)M_ALL * 1024 * 2;
constexpr size_t BIG_P = 0, BIG_MB = (size_t)M_ALL * 4096 * 2;
static_assert(BIG_MB + (size_t)M_ALL * 1024 * 2 <= BIG_END, "overlay");
constexpr size_t WS_KERN = WS_BIG + BIG_END;
constexpr size_t WS_SBH = WS_KERN + 2 * MiB;
constexpr size_t WS_END = WS_SBH + 5 * MiB;
constexpr int KSPLIT = 16;

#define DEV __device__ __forceinline__
DEV float bf2f(unsigned short v) { return __uint_as_float((unsigned)v << 16); }
DEV float bflo(unsigned v) { return __uint_as_float(v << 16); }
DEV float bfhi(unsigned v) { return __uint_as_float(v & 0xffff0000u); }
DEV unsigned short f2bf(float f) { return (unsigned short)(cvt_pk_bf16(f, 0.f) & 0xffffu); }
DEV float sigmoidf_(float x) { return __builtin_amdgcn_rcpf(1.f + __expf(-x)); }
DEV float shflx(float v, int lane, int m) { return __int_as_float(__builtin_amdgcn_ds_bpermute((lane ^ m) << 2, __float_as_int(v))); }
DEV float wave_sum(float v, int lane) {
#pragma unroll
    for (int o = 1; o < 64; o <<= 1) v += shflx(v, lane, o);
    return v;
}
DEV int clampi(int v, int lo, int hi) { return v < lo ? lo : (v > hi ? hi : v); }

struct KP {
    const float* in[35];
    float* out; unsigned char* ws;
    int ph_lo, ph_hi;
};
typedef const __attribute__((address_space(4))) KP* KPP;

struct EpiSwiglu {
    static constexpr bool PERM = true;
    bf16_t* O;
    DEV void operator()(const f32x4 (&acc)[2][2][4][2], const Unit& u, int wr, int wc, int fr, int fq) const {
#pragma unroll
        for (int ai = 0; ai < 2; ++ai)
#pragma unroll
            for (int m = 0; m < 4; ++m) {
                const int row = u.pm * 256 + ai * 128 + wr * 64 + m * 16 + fr;
                float v[8];
#pragma unroll
                for (int n = 0; n < 2; ++n) { const f32x4 g = acc[ai][0][m][n], up = acc[ai][1][m][n];
#pragma unroll
                    for (int j = 0; j < 4; ++j) v[n * 4 + j] = g[j] * sigmoidf_(g[j]) * up[j]; }
                u32x4 w; w.x = cvt_pk_bf16(v[0], v[1]); w.y = cvt_pk_bf16(v[2], v[3]); w.z = cvt_pk_bf16(v[4], v[5]); w.w = cvt_pk_bf16(v[6], v[7]);
                *(u32x4*)(O + (size_t)row * DFF + u.pn * 128 + wc * 32 + fq * 8) = w;
            }
    }
};
struct EpiResid {
    static constexpr bool PERM = false;
    const float* in_lat; const float* in_ctx; float* out_lat; float* out_ctx; const float* gate;   float s;
    DEV void operator()(const f32x4 (&acc)[2][2][4][2], const Unit& u, int wr, int wc, int fr, int fq) const {
        const bool lat = u.pm < 64; const int v = lat ? (u.pm >> 4) : 4;
        const float* gv = gate + (size_t)v * 9 * 1024;
        const float* ib = lat ? in_lat : in_ctx - (size_t)M_LAT * D; float* ob = lat ? out_lat : out_ctx - (size_t)M_LAT * D;
#pragma unroll
        for (int bj = 0; bj < 2; ++bj) {
            const int col = u.pn * 256 + bj * 128 + wc * 32 + fq * 4;
            const f32x4 g0 = *(const f32x4*)(gv + col) * s, g1 = *(const f32x4*)(gv + col + 16) * s;
#pragma unroll
            for (int ai = 0; ai < 2; ++ai) {
                f32x4 b4[4][2];
#pragma unroll
                for (int m = 0; m < 4; ++m) { const float* rp = ib + (size_t)(u.pm * 256 + ai * 128 + wr * 64 + m * 16 + fr) * D + col; b4[m][0] = *(const f32x4*)rp; b4[m][1] = *(const f32x4*)(rp + 16); }
                __builtin_amdgcn_sched_barrier(0);
#pragma unroll
                for (int m = 0; m < 4; ++m) { float* wp = ob + (size_t)(u.pm * 256 + ai * 128 + wr * 64 + m * 16 + fr) * D + col;
                    *(f32x4*)wp = b4[m][0] + g0 * acc[ai][bj][m][0]; *(f32x4*)(wp + 16) = b4[m][1] + g1 * acc[ai][bj][m][1]; }
            }
        }
    }
};
struct EpiStore {
    static constexpr bool PERM = true;
    bf16_t* O; int ldc;
    DEV void operator()(const f32x4 (&acc)[2][2][4][2], const Unit& u, int wr, int wc, int fr, int fq) const {
#pragma unroll
        for (int ai = 0; ai < 2; ++ai)
#pragma unroll
            for (int m = 0; m < 4; ++m) {
                bf16_t* rp = O + (size_t)(u.pm * 256 + ai * 128 + wr * 64 + m * 16 + fr) * ldc + u.pn * 256 + wc * 32 + fq * 8;
#pragma unroll
                for (int bj = 0; bj < 2; ++bj) { const f32x4 v0 = acc[ai][bj][m][0], v1 = acc[ai][bj][m][1];
                    u32x4 w; w.x = cvt_pk_bf16(v0[0], v0[1]); w.y = cvt_pk_bf16(v0[2], v0[3]); w.z = cvt_pk_bf16(v1[0], v1[1]); w.w = cvt_pk_bf16(v1[2], v1[3]);
                    *(u32x4*)(rp + bj * 128) = w; }
            }
    }
};
struct EpiGlu {
    static constexpr bool PERM = true;
    const bf16_t* G5; const float* bias; bf16_t* Y;
    DEV void operator()(const f32x4 (&acc)[2][2][4][2], const Unit& u, int wr, int wc, int fr, int fq) const {
#pragma unroll
        for (int bj = 0; bj < 2; ++bj) {
            const int col = u.pn * 256 + bj * 128 + wc * 32 + fq * 8;
            const f32x4 b0 = *(const f32x4*)(bias + col), b1 = *(const f32x4*)(bias + col + 4);
#pragma unroll
            for (int ai = 0; ai < 2; ++ai)
#pragma unroll
                for (int m = 0; m < 4; ++m) {
                    const int row = u.pm * 256 + ai * 128 + wr * 64 + m * 16 + fr;
                    const u32x4 gw = *(const u32x4*)(G5 + (size_t)row * 512 + col);
                    const f32x4 a0 = acc[ai][bj][m][0] + b0, a1 = acc[ai][bj][m][1] + b1;
                    u32x4 w;
                    w.x = cvt_pk_bf16(bflo(gw.x) * sigmoidf_(a0[0]), bfhi(gw.x) * sigmoidf_(a0[1])); w.y = cvt_pk_bf16(bflo(gw.y) * sigmoidf_(a0[2]), bfhi(gw.y) * sigmoidf_(a0[3]));
                    w.z = cvt_pk_bf16(bflo(gw.z) * sigmoidf_(a1[0]), bfhi(gw.z) * sigmoidf_(a1[1])); w.w = cvt_pk_bf16(bflo(gw.w) * sigmoidf_(a1[2]), bfhi(gw.w) * sigmoidf_(a1[3]));
                    *(u32x4*)(Y + (size_t)row * 2048 + 1024 + col) = w;
                }
        }
    }
};
struct EpiMerge {
    static constexpr bool PERM = false;
    const bf16_t* P; bf16_t* MB;
    DEV void operator()(const f32x4 (&acc)[2][2][4][2], const Unit& u, int wr, int wc, int fr, int fq) const {
        const int c = u.pn * 64 + wc * 16 + fq * 4;
#pragma unroll
        for (int ai = 0; ai < 2; ++ai) {
            u32x2 pw[4][4];
#pragma unroll
            for (int m = 0; m < 4; ++m) { const bf16_t* pr = P + (size_t)(u.pm * 256 + ai * 128 + wr * 64 + m * 16 + fr) * 4096 + c;
#pragma unroll
                for (int q = 0; q < 4; ++q) pw[m][q] = *(const u32x2*)(pr + q * 1024); }
            __builtin_amdgcn_sched_barrier(0);
#pragma unroll
            for (int m = 0; m < 4; ++m) {
                const int row = u.pm * 256 + ai * 128 + wr * 64 + m * 16 + fr;
                f32x4 v = (f32x4){0.f, 0.f, 0.f, 0.f};
#pragma unroll
                for (int bj = 0; bj < 2; ++bj)
#pragma unroll
                    for (int n = 0; n < 2; ++n) {
                        const u32x2 w2 = pw[m][2 * bj + n]; const f32x4 a4 = acc[ai][bj][m][n];
                        v[0] += bflo(w2.x) * sigmoidf_(a4[0]); v[1] += bfhi(w2.x) * sigmoidf_(a4[1]); v[2] += bflo(w2.y) * sigmoidf_(a4[2]); v[3] += bfhi(w2.y) * sigmoidf_(a4[3]);
                    }
                u32x2 w; w.x = cvt_pk_bf16(v[0], v[1]); w.y = cvt_pk_bf16(v[2], v[3]);
                *(u32x2*)(MB + (size_t)row * D + c) = w;
            }
        }
    }
};

DEV const float* wsrc(const float* src, const float* src2, int map, int n) {
    switch (map) {
        case 1: { const int t = n >> 8, r = n & 255; return (r < 128) ? src + t * 128 + r : src2 + t * 128 + r - 128; }
        case 2: { if (n < 3232) return src + n; return nullptr; }
        case 3: { const int pn = n >> 8, loc = n & 255, bj = loc >> 7, wc = (loc >> 5) & 3, n16 = (loc >> 4) & 1, i = loc & 15; return src + 3232 + (2 * bj + n16) * 1024 + pn * 64 + wc * 16 + i; }
        case 5: { const int br = n >> 10, dd = n & 1023; return src + (size_t)br * 512 * 1024 + dd; }
        default: return src + n;
    }
}
DEV void wprep_item(const float* src, const float* src2, bf16_t* dst, int srcN, int K, int map, int item, float* scr  , int lane) {
    const int nkb = K / 64, nb = item / nkb, kb = item % nkb, k0 = kb * 64, n0 = nb * 64;
    const float* cp = wsrc(src, src2, map, n0 + (lane & 15) * 4);
    f32x4 v[16];
#pragma unroll
    for (int i = 0; i < 16; ++i) { const int kk = 4 * i + (lane >> 4); v[i] = cp ? *(const f32x4*)(cp + (size_t)(k0 + kk) * srcN) : (f32x4){0.f, 0.f, 0.f, 0.f}; }
#pragma unroll
    for (int i = 0; i < 16; ++i) { float* w = scr + (4 * i + (lane >> 4)) * 65 + (lane & 15) * 4; w[0] = v[i][0]; w[1] = v[i][1]; w[2] = v[i][2]; w[3] = v[i][3]; }
    asm volatile("s_waitcnt lgkmcnt(0)" ::: "memory");
    const int c = lane & 7;
#pragma unroll
    for (int j = 0; j < 8; ++j) { const int n = (lane >> 3) + 8 * j; const float* s = scr + (8 * c) * 65 + n;
        u32x4 o; o.x = cvt_pk_bf16(s[0 * 65], s[1 * 65]); o.y = cvt_pk_bf16(s[2 * 65], s[3 * 65]); o.z = cvt_pk_bf16(s[4 * 65], s[5 * 65]); o.w = cvt_pk_bf16(s[6 * 65], s[7 * 65]);
        *(u32x4*)(dst + (size_t)(n0 + n) * K + k0 + 8 * c) = o; }
    asm volatile("s_waitcnt lgkmcnt(0)" ::: "memory");
}
DEV void wprep_phase(const int TID, KPP p, unsigned char* lds, int layer, int which) {
    const int lane = TID & 63, wid = __builtin_amdgcn_readfirstlane(TID >> 6);
    __syncthreads();
    float* scr = (float*)(lds + wid * 16640);
    const int gw = wid * gridDim.x + blockIdx.x, NGW = gridDim.x * NWAVES;
    unsigned char* wbp = p->ws + WS_WB;
    const int total = which ? 2112 : 4880;
    for (int it0 = gw; it0 < total; it0 += NGW) {
        int it = __builtin_amdgcn_readfirstlane(it0);
        const float* src; const float* src2; bf16_t* dst; int srcN, K, map;
#define WJ(cnt, S, S2, OFF, SRCN, KK, MAP) if (it < (cnt)) { src = (S); src2 = (S2); dst = (bf16_t*)(wbp + (OFF)); srcN = (SRCN); K = (KK); map = (MAP); } else { it -= (cnt);
        if (which == 0) {
            WJ(1408, p->in[7] + (size_t)layer * D * DFF, p->in[8] + (size_t)layer * D * DFF, WB_GU, DFF, D, 1)
            WJ(704, p->in[9] + (size_t)layer * DFF * D, src, WB_DN, D, DFF, 0)
            WJ(832, p->in[11] + (size_t)layer * D * INCOLS, src, WB_INA, INCOLS, D, 2)
            WJ(1024, p->in[11] + (size_t)layer * D * INCOLS, src, WB_G, INCOLS, D, 3)
            WJ(48, p->in[25] + (size_t)layer * 256 * 768, src, WB_UQ, 768, 256, 0)
            WJ(32, p->in[27] + (size_t)layer * 128 * 1024, src, WB_UKV, 1024, 128, 0)
            WJ(512, p->in[28] + (size_t)layer * 4 * 512 * 1024, src, WB_BR, 1024, 512, 5)
            WJ(256, p->in[29] + (size_t)layer * D * D, src, WB_OUT, D, D, 0)
            { src = p->in[22] + (size_t)layer * 512 * 512; src2 = src; dst = (bf16_t*)(wbp + WB_GLU); srcN = 512; K = 512; map = 0; }
            }}}}}}}}
        } else {
            WJ(1408, p->in[31] + (size_t)layer * D * DFF, p->in[32] + (size_t)layer * D * DFF, WB_GU, DFF, D, 1)
            { src = p->in[33] + (size_t)layer * DFF * D; src2 = src; dst = (bf16_t*)(wbp + WB_DN); srcN = D; K = DFF; map = 0; }
            }
        }
#undef WJ
        wprep_item(src, src2, dst, srcN, K, map, it, scr, lane);
    }
    __syncthreads();
}

DEV void modp_phase(const int TID, KPP p, unsigned char* lds) {
    float* S = (float*)lds;
    const int tid = TID, lane = tid & 63, wid = tid >> 6;
    __syncthreads();
    for (int i = tid; i < 5 * 1024; i += NTHREADS) { const float x = (i < 4096) ? p->in[1][i] : p->in[3][i - 4096]; S[i] = x * sigmoidf_(x); }
    __syncthreads();
    float* MOD = (float*)(p->ws + WS_MOD);
    const int gw = wid * gridDim.x + blockIdx.x, NGW = gridDim.x * NWAVES;
    for (int it = gw; it < 2 * 144 * KSPLIT; it += NGW) {
        const int ks = it % KSPLIT, jb = (it / KSPLIT) % 144, l = it / (KSPLIT * 144);
        const float* W = p->in[4] + (size_t)l * D * 9216 + jb * 64 + lane;
        float a0 = 0.f, a1 = 0.f, a2 = 0.f, a3 = 0.f, a4 = 0.f;
#pragma unroll 8
        for (int kk = 0; kk < 64; ++kk) { const int k = ks * 64 + kk; const float w = W[(size_t)k * 9216];
            a0 += S[k] * w; a1 += S[1024 + k] * w; a2 += S[2048 + k] * w; a3 += S[3072 + k] * w; a4 += S[4096 + k] * w; }
        float* o = MOD + (size_t)l * 5 * 9216 + jb * 64 + lane;
        const float bs = (ks == 0) ? p->in[5][l * 9216 + jb * 64 + lane] : 0.f;
        atomicAdd(o, a0 + bs); atomicAdd(o + 9216, a1 + bs); atomicAdd(o + 2 * 9216, a2 + bs); atomicAdd(o + 3 * 9216, a3 + bs); atomicAdd(o + 4 * 9216, a4 + bs);
    }
    __syncthreads();
}
DEV void norm_phase(const int TID, KPP p, const float* hlat, const float* hctx, const float* w, const float* modl  , int ishift, int nrows) {
    bf16_t* XN = (bf16_t*)(p->ws + WS_XN);
    const int lane = TID & 63, wid = TID >> 6;
    const int gw = wid * gridDim.x + blockIdx.x, NGW = gridDim.x * NWAVES;
    for (int r = gw; r < nrows; r += NGW) {
        const float* xr = (r < M_LAT) ? hlat + (size_t)r * D : hctx + (size_t)(r - M_LAT) * D;
        const int v = (r < M_LAT) ? (r >> 12) : 4;
        const float* sh = modl + ((size_t)v * 9 + ishift) * 1024; const float* sc = sh + 1024;
        f32x4 x[4]; float ss = 0.f;
#pragma unroll
        for (int j = 0; j < 4; ++j) { x[j] = *(const f32x4*)(xr + j * 256 + lane * 4); ss += x[j][0] * x[j][0] + x[j][1] * x[j][1] + x[j][2] * x[j][2] + x[j][3] * x[j][3]; }
        const float rs = rsqrtf(wave_sum(ss, lane) * (1.f / D) + EPS);
#pragma unroll
        for (int j = 0; j < 4; ++j) {
            const int c = j * 256 + lane * 4;
            const f32x4 w4 = *(const f32x4*)(w + c), s4 = *(const f32x4*)(sh + c), c4 = *(const f32x4*)(sc + c);
            const f32x4 y = x[j] * rs * w4 * (c4 + 1.f) + s4;
            u32x2 o; o.x = cvt_pk_bf16(y[0], y[1]); o.y = cvt_pk_bf16(y[2], y[3]);
            *(u32x2*)(XN + (size_t)r * D + c) = o;
        }
    }
}
DEV void rope_inplace(bf16_t* x1p, bf16_t* x2p, float pos, float invf) {
    const float ang = pos * invf, cs = __cosf(ang), sn = __sinf(ang);
    const float a = bf2f(*x1p), b = bf2f(*x2p);
    *x1p = f2bf(a * cs - b * sn); *x2p = f2bf(b * cs + a * sn);
}
DEV void mlanorm_phase(const int TID, KPP p, const float* qw, const float* kvw) {
    bf16_t* WA = (bf16_t*)(p->ws + WS_BIG + BIG_WA);
    const int lane = TID & 63, wid = TID >> 6;
    const int gw = wid * gridDim.x + blockIdx.x, NGW = gridDim.x * NWAVES;
    const bool ract = lane < 42;
    int rbase, rxoff, ri0, rpt; float rfd;
    if (lane < 32) { const int hd = lane >> 2, hf = lane & 1; rpt = (lane >> 1) & 1; rbase = C_SWQ + hd * 64 + rpt * 32 + hf * 8; rxoff = 16; ri0 = hf * 8; rfd = 13.287712379549449f / 16.f; }
    else if (lane < 40) { const int l2 = lane - 32, hd = l2 >> 2, hf = l2 & 1; rpt = (l2 >> 1) & 1; rbase = C_SWK + hd * 64 + rpt * 32 + hf * 8; rxoff = 16; ri0 = hf * 8; rfd = 13.287712379549449f / 16.f; }
    else { rpt = (lane - 40) & 1; rbase = C_KR + rpt * 16; rxoff = 8; ri0 = 0; rfd = 13.287712379549449f / 8.f; }
    float rinvf[8];
#pragma unroll
    for (int j = 0; j < 8; ++j) rinvf[j] = __builtin_amdgcn_exp2f(-(float)(ri0 + j) * rfd);
    for (int r = gw; r < M_ALL; r += NGW) {
        bf16_t* q = WA + (size_t)r * WA_N + C_CQ + lane * 4;
        const u32x2 qv = *(const u32x2*)q;
        const float q0 = bflo(qv.x), q1 = bfhi(qv.x), q2 = bflo(qv.y), q3 = bfhi(qv.y);
        const float rq = rsqrtf(wave_sum(q0 * q0 + q1 * q1 + q2 * q2 + q3 * q3, lane) * (1.f / 256.f) + EPS);
        const f32x4 w4 = *(const f32x4*)(qw + lane * 4);
        u32x2 o; o.x = cvt_pk_bf16(q0 * rq * w4[0], q1 * rq * w4[1]); o.y = cvt_pk_bf16(q2 * rq * w4[2], q3 * rq * w4[3]);
        *(u32x2*)q = o;
        bf16_t* k = WA + (size_t)r * WA_N + C_CKV + lane * 2;
        const unsigned kv = *(const unsigned*)k;
        const float k0 = bflo(kv), k1 = bfhi(kv);
        const float rk = rsqrtf(wave_sum(k0 * k0 + k1 * k1, lane) * (1.f / 128.f) + EPS);
        *(unsigned*)k = cvt_pk_bf16(k0 * rk * kvw[lane * 2], k1 * rk * kvw[lane * 2 + 1]);
        if (r < M_LAT && ract) {
            const int t = r & 4095; const float pos = (float)(rpt ? (t & 63) : (t >> 6));
            bf16_t* x1p = WA + (size_t)r * WA_N + rbase;
            const u32x4 a = *(const u32x4*)x1p, b2 = *(const u32x4*)(x1p + rxoff);
            const float av[8] = {bflo(a.x), bfhi(a.x), bflo(a.y), bfhi(a.y), bflo(a.z), bfhi(a.z), bflo(a.w), bfhi(a.w)};
            const float bv[8] = {bflo(b2.x), bfhi(b2.x), bflo(b2.y), bfhi(b2.y), bflo(b2.z), bfhi(b2.z), bflo(b2.w), bfhi(b2.w)};
            float o1[8], o2[8];
#pragma unroll
            for (int j = 0; j < 8; ++j) { const float ang = pos * rinvf[j], cs = __cosf(ang), sn = __sinf(ang); o1[j] = av[j] * cs - bv[j] * sn; o2[j] = bv[j] * cs + av[j] * sn; }
            u32x4 w1, w2; w1.x = cvt_pk_bf16(o1[0], o1[1]); w1.y = cvt_pk_bf16(o1[2], o1[3]); w1.z = cvt_pk_bf16(o1[4], o1[5]); w1.w = cvt_pk_bf16(o1[6], o1[7]);
            w2.x = cvt_pk_bf16(o2[0], o2[1]); w2.y = cvt_pk_bf16(o2[2], o2[3]); w2.z = cvt_pk_bf16(o2[4], o2[5]); w2.w = cvt_pk_bf16(o2[6], o2[7]);
            *(u32x4*)x1p = w1; *(u32x4*)(x1p + rxoff) = w2;
        }
    }
}
DEV void final_phase(const int TID, KPP p) {
    const float* w = p->in[34];
    const int lane = TID & 63, wid = TID >> 6;
    const int gw = wid * gridDim.x + blockIdx.x, NGW = gridDim.x * NWAVES;
    for (int r = gw; r < M_LAT; r += NGW) {
        float* xr = p->out + (size_t)r * D;
        f32x4 x[4]; float ss = 0.f;
#pragma unroll
        for (int j = 0; j < 4; ++j) { x[j] = *(const f32x4*)(xr + j * 256 + lane * 4); ss += x[j][0] * x[j][0] + x[j][1] * x[j][1] + x[j][2] * x[j][2] + x[j][3] * x[j][3]; }
        const float rs = rsqrtf(wave_sum(ss, lane) * (1.f / D) + EPS);
#pragma unroll
        for (int j = 0; j < 4; ++j) { const int c = j * 256 + lane * 4; *(f32x4*)(xr + c) = x[j] * rs * *(const f32x4*)(w + c); }
    }
}

struct S5L { const float *lre, *lim, *ldt, *bre, *bim, *cre, *cim, *dsk; };
DEV void s5_lambar(const S5L& L, int gi, int pp, float& lre, float& lim, float& dt, float& lbr, float& lbi) {
    lre = L.lre[gi * 64 + pp]; lim = L.lim[gi * 64 + pp]; dt = __expf(L.ldt[gi]);
    const float er = __expf(lre * dt), ang = lim * dt;
    lbr = er * cosf(ang); lbi = er * sinf(ang);
}
DEV void s5_coef(float lre, float lim, float lbr, float lbi, float& cr, float& ci) {
    const float ar = lbr - 1.f, ai = lbi, den = 1.f / (lre * lre + lim * lim);
    cr = (ar * lre + ai * lim) * den; ci = (ai * lre - ar * lim) * den;
}
DEV int s5_row(int b, int dir, int k, int s) {
    const int pos = k * 64 + s;
    if (dir == 0) return pos < 256 ? M_LAT + b * 256 + pos : b * 4096 + (pos - 256);
    return pos < 256 ? M_LAT + b * 256 + (255 - pos) : b * 4096 + (4095 - (pos - 256));
}
DEV void s5_pre_phase(const int TID, KPP p, const S5L& L, unsigned char* lds, const int b0, const int nbk) {
    if ((int)blockIdx.x < b0) return;
    const int bj = (int)blockIdx.x - b0;
    bf16_t* KERN = (bf16_t*)(p->ws + WS_KERN); bf16_t* W3 = (bf16_t*)(p->ws + WS_WB);
    float2* Cs = (float2*)lds; float2* Bs = Cs + 1024; float2* PWs = Bs + 1024;
    for (int it = bj; it < 256; it += nbk) {
        const int dg = it >> 2, dq = it & 3;
        __syncthreads();
        for (int idx = TID; idx < 1024; idx += NTHREADS) {
            { const int c = idx >> 6, pp = idx & 63; Cs[idx] = make_float2(L.cre[(dg * 16 + c) * 64 + pp], L.cim[(dg * 16 + c) * 64 + pp]); }
            { const int pp = idx >> 4, c2 = idx & 15; float lre, lim, dt, lbr, lbi, cr, ci; s5_lambar(L, dg, pp, lre, lim, dt, lbr, lbi); s5_coef(lre, lim, lbr, lbi, cr, ci);
              const float br = L.bre[(size_t)(dg * 64 + pp) * 16 + c2], bi = L.bim[(size_t)(dg * 64 + pp) * 16 + c2];
              Bs[idx] = make_float2(cr * br - ci * bi, cr * bi + ci * br); }
            { const int dd = idx >> 6, pp = idx & 63; const float d = (float)(dq * 16 + dd);
              const float lre = L.lre[dg * 64 + pp], lim = L.lim[dg * 64 + pp], dt = __expf(L.ldt[dg]);
              const float er = __expf(d * lre * dt), ang = d * lim * dt; PWs[idx] = make_float2(er * cosf(ang), er * sinf(ang)); }
        }
        __syncthreads();
        {
            const int c2h = TID & 1, c = (TID >> 1) & 15, dd = TID >> 5;
            float sum[8];
#pragma unroll
            for (int j = 0; j < 8; ++j) sum[j] = 0.f;
#pragma unroll 4
            for (int pp = 0; pp < 64; ++pp) { const float2 cc = Cs[c * 64 + pp], pw = PWs[dd * 64 + pp];
                const float gr = cc.x * pw.x - cc.y * pw.y, gi = cc.x * pw.y + cc.y * pw.x;
                const f32x4* bp = (const f32x4*)(Bs + pp * 16 + c2h * 8);
#pragma unroll
                for (int q = 0; q < 4; ++q) { const f32x4 b2 = bp[q]; sum[2 * q] += gr * b2[0] - gi * b2[1]; sum[2 * q + 1] += gr * b2[2] - gi * b2[3]; } }
            u32x4 w; w.x = cvt_pk_bf16(sum[0], sum[1]); w.y = cvt_pk_bf16(sum[2], sum[3]); w.z = cvt_pk_bf16(sum[4], sum[5]); w.w = cvt_pk_bf16(sum[6], sum[7]);
            *(u32x4*)(KERN + (size_t)((dg * 64 + dq * 16 + dd) * 16 + c) * 16 + c2h * 8) = w;
        }
    }
    __syncthreads();
    for (int un = (TID >> 6) * nbk + bj; un < 64 * 16; un += nbk * NWAVES) {
        const int pp = TID & 63, c = un & 15, dg = un >> 4;
        float lre, lim, dt, lbr, lbi; s5_lambar(L, dg, pp, lre, lim, dt, lbr, lbi);
        const float cr = L.cre[(dg * 16 + c) * 64 + pp], ci = L.cim[(dg * 16 + c) * 64 + pp];
        float pr = lbr, pi = lbi;
        bf16_t* o = W3 + (size_t)(dg * 64 * 16 + c) * 128 + pp;
#pragma unroll 4
        for (int e = 0; e < 64; ++e) {
            o[(size_t)e * 16 * 128] = f2bf(cr * pr - ci * pi); o[(size_t)e * 16 * 128 + 64] = f2bf(-(cr * pi + ci * pr));
            const float nr = pr * lbr - pi * lbi, ni = pr * lbi + pi * lbr; pr = nr; pi = ni;
        }
    }
}
DEV void s5_local_phase(const int TID, KPP p, const S5L& L) {
    const bf16_t* WA = (const bf16_t*)(p->ws + WS_BIG + BIG_WA); float2* SB = (float2*)(p->ws + WS_S5);
    const int lane = TID & 63, wid = __builtin_amdgcn_readfirstlane(TID >> 6), fr = lane & 15, fq = lane >> 4, sh = fq >> 1, c0 = (fq & 1) * 8;
    const int gw = wid * gridDim.x + blockIdx.x, NGW = gridDim.x * NWAVES;
    for (int it = gw; it < 768; it += NGW) {
        const int nh = it % 3, mbp = (it / 3) & 3, dg = it / 12, dir = dg >> 5, g = dg & 31, pp = mbp * 16 + fr;
        float lre, lim, dt, lbr, lbi, cr, ci; s5_lambar(L, dg, pp, lre, lim, dt, lbr, lbi); s5_coef(lre, lim, lbr, lbi, cr, ci);
        float bbr[8], bbi[8];
        { const f32x4* brp = (const f32x4*)(L.bre + (size_t)(dg * 64 + pp) * 16 + c0); const f32x4* bip = (const f32x4*)(L.bim + (size_t)(dg * 64 + pp) * 16 + c0);
#pragma unroll
          for (int q = 0; q < 2; ++q) { const f32x4 r4 = brp[q], i4 = bip[q];
#pragma unroll
              for (int j = 0; j < 4; ++j) { bbr[q * 4 + j] = cr * r4[j] - ci * i4[j]; bbi[q * 4 + j] = cr * i4[j] + ci * r4[j]; } } }
        const float l2r = lbr * lbr - lbi * lbi, l2i = 2.f * lbr * lbi;
        float pr = sh ? 1.f : lbr, pi = sh ? 0.f : lbi;
        const int NB = (nh < 2) ? 6 : 5, nb0 = nh * 6;
        const bf16_t* ub[6]; int kcol[6];
#pragma unroll
        for (int nb = 0; nb < 6; ++nb) { int col = (nb0 + nb) * 16 + fr; if (col > 271) col = 271; const int b = col / 68, k = col % 68;
            kcol[nb] = (b * 2 + dir) * 68 + k; ub[nb] = WA + (size_t)s5_row(b, dir, k, 0) * WA_N + C_S5U + g * 16 + c0; }
        const ptrdiff_t sstep = (dir == 0) ? (ptrdiff_t)WA_N : -(ptrdiff_t)WA_N;
        f32x4 are[6], aim[6];
#pragma unroll
        for (int nb = 0; nb < 6; ++nb) { are[nb] = (f32x4){0.f, 0.f, 0.f, 0.f}; aim[nb] = (f32x4){0.f, 0.f, 0.f, 0.f}; }
        bf16x8 Bc[6], Bn[6], Bm[6];
#pragma unroll
        for (int nb = 0; nb < 6; ++nb) { Bc[nb] = *(const bf16x8*)(ub[nb] + (ptrdiff_t)(62 + sh) * sstep); Bn[nb] = *(const bf16x8*)(ub[nb] + (ptrdiff_t)(60 + sh) * sstep); Bm[nb] = Bn[nb]; }
#pragma unroll 1
        for (int kc = 31; kc >= 0; --kc) {
            if (kc > 1) {
#pragma unroll
                for (int nb = 0; nb < 6; ++nb) if (nb < NB) Bm[nb] = *(const bf16x8*)(ub[nb] + (ptrdiff_t)(2 * kc - 4 + sh) * sstep);
            }
            u32x4 wr_, wi_;
            wr_.x = cvt_pk_bf16(pr * bbr[0] - pi * bbi[0], pr * bbr[1] - pi * bbi[1]); wr_.y = cvt_pk_bf16(pr * bbr[2] - pi * bbi[2], pr * bbr[3] - pi * bbi[3]);
            wr_.z = cvt_pk_bf16(pr * bbr[4] - pi * bbi[4], pr * bbr[5] - pi * bbi[5]); wr_.w = cvt_pk_bf16(pr * bbr[6] - pi * bbi[6], pr * bbr[7] - pi * bbi[7]);
            wi_.x = cvt_pk_bf16(pr * bbi[0] + pi * bbr[0], pr * bbi[1] + pi * bbr[1]); wi_.y = cvt_pk_bf16(pr * bbi[2] + pi * bbr[2], pr * bbi[3] + pi * bbr[3]);
            wi_.z = cvt_pk_bf16(pr * bbi[4] + pi * bbr[4], pr * bbi[5] + pi * bbr[5]); wi_.w = cvt_pk_bf16(pr * bbi[6] + pi * bbr[6], pr * bbi[7] + pi * bbr[7]);
            const bf16x8 Ar = __builtin_bit_cast(bf16x8, wr_), Ai = __builtin_bit_cast(bf16x8, wi_);
#pragma unroll
            for (int nb = 0; nb < 6; ++nb) if (nb < NB) {
                are[nb] = __builtin_amdgcn_mfma_f32_16x16x32_bf16(Ar, Bc[nb], are[nb], 0, 0, 0);
                aim[nb] = __builtin_amdgcn_mfma_f32_16x16x32_bf16(Ai, Bc[nb], aim[nb], 0, 0, 0);
            }
#pragma unroll
            for (int nb = 0; nb < 6; ++nb) { Bc[nb] = Bn[nb]; Bn[nb] = Bm[nb]; }
            const float nr = pr * l2r - pi * l2i, ni = pr * l2i + pi * l2r; pr = nr; pi = ni;
        }
#pragma unroll
        for (int nb = 0; nb < 6; ++nb) if (nb < NB) {
            float2* o = SB + (size_t)kcol[nb] * 2048 + g * 64 + mbp * 16 + fq * 4;
#pragma unroll
            for (int j = 0; j < 4; ++j) o[j] = make_float2(are[nb][j], aim[nb][j]);
        }
    }
}
DEV void s5_carry_phase(const int TID, KPP p, const S5L& L) {
    const float2* __restrict__ SB = (const float2*)(p->ws + WS_S5); bf16_t* __restrict__ SBH = (bf16_t*)(p->ws + WS_SBH);
    if (TID >= 64) return;
    for (int idx = blockIdx.x * 64 + TID; idx < 4 * 2 * 32 * 64; idx += gridDim.x * 64) {
        const int pp = idx & 63, g = (idx >> 6) & 31, dir = (idx >> 11) & 1, b = idx >> 12;
        float lre, lim, dt, ar, ai; s5_lambar(L, dir * 32 + g, pp, lre, lim, dt, ar, ai);
#pragma unroll
        for (int q = 0; q < 6; ++q) { const float nr = ar * ar - ai * ai, ni = 2.f * ar * ai; ar = nr; ai = ni; }
        float sr = 0.f, si = 0.f;
        const float2* base = SB + (size_t)((b * 2 + dir) * 68) * 2048 + g * 64 + pp;
        bf16_t* ob = SBH + (size_t)((b * 2 + dir) * 68) * 4096 + g * 128 + pp;
#pragma unroll 17
        for (int k = 0; k < 68; ++k) { const float2 e = base[(size_t)k * 2048];
            ob[(size_t)k * 4096] = f2bf(sr); ob[(size_t)k * 4096 + 64] = f2bf(si);
            const float nr = ar * sr - ai * si + e.x, ni = ar * si + ai * sr + e.y; sr = nr; si = ni; }
    }
}
DEV float gelu_tanh(float x) { const float z = 0.7978845608028654f * (x + 0.044715f * x * x * x); const float t = 1.f - 2.f * __builtin_amdgcn_rcpf(1.f + __expf(2.f * z)); return 0.5f * x * (1.f + t); }
DEV void s5_out_phase(const int TID, KPP p, const S5L& L, bool lastl) {
    const bf16_t* WA = (const bf16_t*)(p->ws + WS_BIG + BIG_WA); const bf16_t* SBH = (const bf16_t*)(p->ws + WS_SBH); bf16_t* G5 = (bf16_t*)(p->ws + WS_G5);
    const bf16_t* KERN = (const bf16_t*)(p->ws + WS_KERN); const bf16_t* W3 = (const bf16_t*)(p->ws + WS_WB);
    const int lane = TID & 63, wid = __builtin_amdgcn_readfirstlane(TID >> 6), fr = lane & 15, fq = lane >> 4, sh = fq >> 1, c0 = (fq & 1) * 8;
    const int gw = wid * gridDim.x + blockIdx.x, NGW = gridDim.x * NWAVES;
    const int NG = lastl ? 4 : 5, ncols = lastl ? 256 : 272;
    for (int it = gw; it < 32 * 16 * NG; it += NGW) {
        const int ng = it % NG, tg = (it / NG) & 15, g = it / (NG * 16), t0 = tg * 4;
        int rowb[4]; const bf16_t* sbf[4]; const bf16_t* sbr[4];
#pragma unroll
        for (int nb = 0; nb < 4; ++nb) { int col = (ng * 4 + nb) * 16 + fr; if (col >= ncols) col = ncols - 1;
            const int b = lastl ? (col >> 6) : (col / 68), tc = lastl ? 4 + (col & 63) : (col % 68);
            rowb[nb] = (tc < 4) ? M_LAT + b * 256 + tc * 64 : b * 4096 + (tc - 4) * 64;
            const int kr = (tc < 4) ? 3 - tc : 71 - tc;
            sbf[nb] = SBH + (size_t)(((b * 2 + 0) * 68 + tc) * 32 + g) * 128 + fq * 8; sbr[nb] = SBH + (size_t)(((b * 2 + 1) * 68 + kr) * 32 + g) * 128 + fq * 8; }
        const int nvalid = (ncols - ng * 64 + 15) >> 4;
        f32x4 acc[4][4];
#pragma unroll
        for (int ti = 0; ti < 4; ++ti)
#pragma unroll
            for (int nb = 0; nb < 4; ++nb) acc[ti][nb] = (f32x4){0.f, 0.f, 0.f, 0.f};
        const bf16_t* kf = KERN + (size_t)(g * 64 * 16 + fr) * 16 + c0; const bf16_t* kr_ = KERN + (size_t)((32 + g) * 64 * 16 + fr) * 16 + c0;
#define S5O_LOAD(Bs_, Af_, Ar_, kc_) do { const int _tq = 2 * (kc_) + sh; \
            _Pragma("unroll") for (int nb = 0; nb < 4; ++nb) Bs_[nb] = *(const bf16x8*)(WA + (size_t)(rowb[nb] + _tq) * WA_N + C_S5U + g * 16 + c0); \
            _Pragma("unroll") for (int ti = 0; ti < 4; ++ti) { const int _df = t0 + ti - _tq, _dr = _tq - t0 - ti; \
                u32x4 _a = *(const u32x4*)(kf + (size_t)(_df < 0 ? 0 : _df) * 256); if (_df < 0) _a = (u32x4){0u, 0u, 0u, 0u}; Af_[ti] = __builtin_bit_cast(bf16x8, _a); \
                u32x4 _b = *(const u32x4*)(kr_ + (size_t)(_dr < 0 ? 0 : _dr) * 256); if (_dr < 0) _b = (u32x4){0u, 0u, 0u, 0u}; Ar_[ti] = __builtin_bit_cast(bf16x8, _b); } } while (0)
#define S5O_MMA(Bs_, Af_, Ar_, kc_) do { \
            _Pragma("unroll") for (int ti = 0; ti < 4; ++ti) { const int t = t0 + ti; \
                if (t >= 2 * (kc_)) { _Pragma("unroll") for (int nb = 0; nb < 4; ++nb) if (nb < nvalid) acc[ti][nb] = __builtin_amdgcn_mfma_f32_16x16x32_bf16(Af_[ti], Bs_[nb], acc[ti][nb], 0, 0, 0); } \
                if (2 * (kc_) + 1 >= t) { _Pragma("unroll") for (int nb = 0; nb < 4; ++nb) if (nb < nvalid) acc[ti][nb] = __builtin_amdgcn_mfma_f32_16x16x32_bf16(Ar_[ti], Bs_[nb], acc[ti][nb], 0, 0, 0); } } } while (0)
        {
            bf16x8 B0[4], F0[4], R0[4], B1[4], F1[4], R1[4];
            S5O_LOAD(B0, F0, R0, 0);
#pragma unroll 1
            for (int kc = 0; kc < 32; kc += 2) {
                S5O_LOAD(B1, F1, R1, kc + 1);
                S5O_MMA(B0, F0, R0, kc);
                if (kc + 2 < 32) S5O_LOAD(B0, F0, R0, kc + 2);
                S5O_MMA(B1, F1, R1, kc + 1);
            }
        }
#undef S5O_LOAD
#undef S5O_MMA
#pragma unroll 1
        for (int dir = 0; dir < 2; ++dir)
#pragma unroll
            for (int kc2 = 0; kc2 < 4; ++kc2) {
                bf16x8 B[4];
#pragma unroll
                for (int nb = 0; nb < 4; ++nb) B[nb] = *(const bf16x8*)((dir ? sbr[nb] : sbf[nb]) + kc2 * 32);
#pragma unroll
                for (int ti = 0; ti < 4; ++ti) { const int t = t0 + ti, e = dir ? 63 - t : t;
                    const bf16x8 A = *(const bf16x8*)(W3 + (size_t)(((dir * 32 + g) * 64 + e) * 16 + fr) * 128 + kc2 * 32 + fq * 8);
#pragma unroll
                    for (int nb = 0; nb < 4; ++nb) if (nb < nvalid) acc[ti][nb] = __builtin_amdgcn_mfma_f32_16x16x32_bf16(A, B[nb], acc[ti][nb], 0, 0, 0); }
            }
        const f32x4 dsk = *(const f32x4*)(L.dsk + g * 16 + fq * 4);
#pragma unroll
        for (int nb = 0; nb < 4; ++nb) if (nb < nvalid)
#pragma unroll
            for (int ti = 0; ti < 4; ++ti) {
                const size_t row = (size_t)(rowb[nb] + t0 + ti);
                const u32x2 uw = *(const u32x2*)(WA + row * WA_N + C_S5U + g * 16 + fq * 4);
                const f32x4 a = acc[ti][nb];
                const float y0 = gelu_tanh(a[0] + dsk[0] * bflo(uw.x)), y1 = gelu_tanh(a[1] + dsk[1] * bfhi(uw.x)), y2 = gelu_tanh(a[2] + dsk[2] * bflo(uw.y)), y3 = gelu_tanh(a[3] + dsk[3] * bfhi(uw.y));
                u32x2 w; w.x = cvt_pk_bf16(y0, y1); w.y = cvt_pk_bf16(y2, y3);
                *(u32x2*)(G5 + row * 512 + g * 16 + fq * 4) = w;
            }
    }
}

struct AttnP { const bf16_t* WA; const bf16_t* MLAQ; const bf16_t* MLAKV; bf16_t* Y; const float* rpb; const float* sink; };
typedef float f32x16 __attribute__((ext_vector_type(16)));
DEV float half_max(float x) { auto q = __builtin_amdgcn_permlane32_swap(__float_as_uint(x), __float_as_uint(x), false, false); return fmaxf(__uint_as_float(q[0]), __uint_as_float(q[1])); }
DEV float half_sum(float x) { auto q = __builtin_amdgcn_permlane32_swap(__float_as_uint(x), __float_as_uint(x), false, false); return __uint_as_float(q[0]) + __uint_as_float(q[1]); }
template <int TYPE  >
DEV void attn_item(const int TID, unsigned char* lds, const AttnP& P, int b, int h, int qt) {
    constexpr int DQ = (TYPE == 2) ? 96 : 64, NC = DQ / 16, KPI = DQ + 8, VPI = 68, BUFSZ = 22016;
    float* rp = (float*)(lds + 2 * BUFSZ);
    const int tid = TID, lane = tid & 63, wid = __builtin_amdgcn_readfirstlane(tid >> 6), l31 = lane & 31, hi = lane >> 5;
    const bool cq = (qt == 16);
    const int qrow0 = cq ? M_LAT + b * 256 : b * 4096 + qt * 256;
    const bf16_t *Qp, *K0p, *Vp; int qpitch, kpitch;
    if (TYPE == 0) { Qp = P.WA + C_NAQ + h * 64; qpitch = WA_N; K0p = P.WA + C_NAK + h * 64; Vp = P.WA + C_NAV + h * 64; kpitch = WA_N; }
    else if (TYPE == 1) { Qp = P.WA + C_SWQ + h * 64; qpitch = WA_N; K0p = P.WA + C_SWK + (h >> 2) * 64; Vp = P.WA + C_SWV + (h >> 2) * 64; kpitch = WA_N; }
    else { Qp = P.MLAQ + h * 96; qpitch = 768; K0p = P.MLAKV + h * 128; Vp = P.MLAKV + h * 128 + 64; kpitch = 1024; }
    const bf16_t* K1p = P.WA + C_KR;
    int lo = 0, hi_t = 0, wlo = 0, whi = 0;
    const int qw = qt * 256 + wid * 32;
    if (!cq) {
        if (TYPE == 0) { lo = clampi(qt * 4 - 4, 0, 56); hi_t = clampi(qt * 4 + 3 - 4, 0, 56) + 8; wlo = clampi((qw >> 6) - 4, 0, 56); whi = wlo + 8; }
        else if (TYPE == 1) { lo = qt * 4 - 2; if (lo < 0) lo = 0; hi_t = qt * 4 + 6; if (hi_t > 64) hi_t = 64;
            wlo = (qw - 128 < 0 ? 0 : qw - 128) >> 6; whi = ((qw + 31 + 128) >> 6) + 1; if (whi > 64) whi = 64; }
        else { lo = 0; hi_t = 64; wlo = 0; whi = 64; }
    }
    const int nloc = hi_t - lo, nt = nloc + 4;
    const float sc = ((TYPE == 2) ? 0.10206207261596575f : 0.125f) * LOG2E;
    __syncthreads();
    if (TYPE == 0 && !cq && tid < 465) rp[tid] = P.rpb[h * 465 + tid] * LOG2E;
    const int qrow = qrow0 + wid * 32 + l31;
    bf16x8 Qf[NC];
#pragma unroll
    for (int c = 0; c < NC; ++c) {
        const u32x4 w = *(const u32x4*)(Qp + (size_t)qrow * qpitch + c * 16 + hi * 8);
        float v[8] = {bflo(w.x), bfhi(w.x), bflo(w.y), bfhi(w.y), bflo(w.z), bfhi(w.z), bflo(w.w), bfhi(w.w)};
        if (TYPE == 2 && c >= 4 && !cq) {
            const int t = qrow & 4095; const float pos = (float)((c == 5) ? (t & 63) : (t >> 6));
#pragma unroll
            for (int j = 0; j < 8; ++j) {
                const float other = shflx(v[j], lane, 32);
                const float ang = pos * __builtin_amdgcn_exp2f(-(float)j * (13.287712379549449f / 8.f)), cs = __cosf(ang), sn = __sinf(ang);
                v[j] = hi ? (v[j] * cs + other * sn) : (v[j] * cs - other * sn);
            }
        }
        u32x4 o; o.x = cvt_pk_bf16(v[0] * sc, v[1] * sc); o.y = cvt_pk_bf16(v[2] * sc, v[3] * sc); o.z = cvt_pk_bf16(v[4] * sc, v[5] * sc); o.w = cvt_pk_bf16(v[6] * sc, v[7] * sc);
        Qf[c] = __builtin_bit_cast(bf16x8, o);
    }
    f32x16 O[2]; float mrun, lrun;
#pragma unroll
    for (int db = 0; db < 2; ++db)
#pragma unroll
        for (int r = 0; r < 16; ++r) O[db][r] = 0.f;
    if (TYPE == 1) { mrun = P.sink[h] * LOG2E; lrun = (hi == 0) ? 1.f : 0.f; } else { mrun = -1e30f; lrun = 0.f; }
    const int qtok = qw + l31, qr = qtok >> 6, qc = qtok & 63, r0 = clampi(qr - 4, 0, 56), c0 = clampi(qc - 8, 0, 48);
    u32x4 kr0, kr1, vr; kr1 = (u32x4){0u, 0u, 0u, 0u};
    auto tile_row0 = [&](int i) { return (i < nloc) ? b * 4096 + (lo + i) * 64 : M_LAT + b * 256 + (i - nloc) * 64; };
#define ATT_PREFETCH(i) do { const int _r0 = tile_row0(i); \
        kr0 = *(const u32x4*)(K0p + (size_t)(_r0 + (tid >> 3)) * kpitch + (tid & 7) * 8); \
        if (TYPE == 2 && tid < 256) kr1 = *(const u32x4*)(K1p + (size_t)(_r0 + (tid >> 2)) * WA_N + (tid & 3) * 8); \
        vr = *(const u32x4*)(Vp + (size_t)(_r0 + (tid >> 3)) * kpitch + (tid & 7) * 8); } while (0)
#define ATT_WRITE(bufi) do { bf16_t* _Ks = (bf16_t*)(lds + (bufi) * BUFSZ); bf16_t* _Vt = (bf16_t*)(lds + (bufi) * BUFSZ + 64 * KPI * 2); \
        *(u32x4*)(_Ks + (tid >> 3) * KPI + (tid & 7) * 8) = kr0; \
        if (TYPE == 2 && tid < 256) *(u32x4*)(_Ks + (tid >> 2) * KPI + 64 + (tid & 3) * 8) = kr1; \
        bf16_t* vp = _Vt + ((tid & 7) * 8) * VPI + ((tid >> 3) ^ ((tid & 7) * 8));   \
        vp[0 * VPI] = (bf16_t)(vr.x & 0xffffu); vp[1 * VPI] = (bf16_t)(vr.x >> 16); vp[2 * VPI] = (bf16_t)(vr.y & 0xffffu); vp[3 * VPI] = (bf16_t)(vr.y >> 16); \
        vp[4 * VPI] = (bf16_t)(vr.z & 0xffffu); vp[5 * VPI] = (bf16_t)(vr.z >> 16); vp[6 * VPI] = (bf16_t)(vr.w & 0xffffu); vp[7 * VPI] = (bf16_t)(vr.w >> 16); } while (0)
    ATT_PREFETCH(0); ATT_WRITE(0); ATT_PREFETCH(1);
    __syncthreads();
    for (int i = 0; i < nt; ++i) {
        const bf16_t* Ks = (const bf16_t*)(lds + (i & 1) * BUFSZ); const bf16_t* Vt = (const bf16_t*)(lds + (i & 1) * BUFSZ + 64 * KPI * 2);
        const bool local = i < nloc; const int kt = lo + i;
        if (!(local && (kt < wlo || kt >= whi))) {
        f32x16 S[2];
#pragma unroll
        for (int kb = 0; kb < 2; ++kb) {
            bf16x8 Kf[NC];
#pragma unroll
            for (int c = 0; c < NC; ++c) Kf[c] = *(const bf16x8*)(Ks + (kb * 32 + l31) * KPI + c * 16 + hi * 8);
            __builtin_amdgcn_sched_barrier(0);
            f32x16 acc;
#pragma unroll
            for (int r = 0; r < 16; ++r) acc[r] = 0.f;
#pragma unroll
            for (int c = 0; c < NC; ++c) acc = __builtin_amdgcn_mfma_f32_32x32x16_bf16(Kf[c], Qf[c], acc, 0, 0, 0);
            S[kb] = acc;
            __builtin_amdgcn_sched_barrier(0);
        }
        u32x2 Vf[4][2];
#pragma unroll
        for (int ck = 0; ck < 4; ++ck) { const bf16_t* vp = Vt + l31 * VPI; const int sw = (l31 >> 3) * 8; Vf[ck][0] = *(const u32x2*)(vp + ((ck * 16 + hi * 4) ^ sw)); Vf[ck][1] = *(const u32x2*)(vp + ((ck * 16 + 8 + hi * 4) ^ sw)); }
        __builtin_amdgcn_sched_barrier(0);
        float mx = -1e30f;
#pragma unroll
        for (int kb = 0; kb < 2; ++kb)
#pragma unroll
            for (int r = 0; r < 16; ++r) {
                const int kk = kb * 32 + (r & 3) + 8 * (r >> 2) + 4 * hi;
                float t = S[kb][r];
                if (TYPE != 2 && local) {
                    if (TYPE == 0) { const bool ok = ((unsigned)(kt - r0) < 8u) && ((unsigned)(kk - c0) < 16u);
                        if (ok) t += rp[(kt - qr + 7) * 31 + (kk - qc + 15)]; else t = -1e30f; }
                    else if (TYPE == 1) { int dlt = qtok - (kt * 64 + kk); if (dlt < 0) dlt = -dlt; if (dlt > 128) t = -1e30f; }
                    S[kb][r] = t;
                }
                mx = fmaxf(mx, t);
            }
        mx = half_max(mx);
        float mn = mrun;
        if (__builtin_amdgcn_ballot_w64(mx > mrun + 8.f)) {
            mn = fmaxf(mrun, mx); const float alpha = __builtin_amdgcn_exp2f(mrun - mn); mrun = mn; lrun *= alpha;
#pragma unroll
            for (int db = 0; db < 2; ++db) O[db] *= alpha;
        }
        float ps = 0.f;
#pragma unroll
        for (int kb = 0; kb < 2; ++kb)
#pragma unroll
            for (int r = 0; r < 16; ++r) { const float t = S[kb][r];
                float pv = __builtin_amdgcn_exp2f(t - mn); if (TYPE != 2) pv = (t > -1e29f) ? pv : 0.f;
                S[kb][r] = pv; ps += pv; }
        lrun += ps;
        bf16x8 Pf[4];
#pragma unroll
        for (int kb = 0; kb < 2; ++kb)
#pragma unroll
            for (int m = 0; m < 2; ++m) { u32x4 w; w.x = cvt_pk_bf16(S[kb][8 * m], S[kb][8 * m + 1]); w.y = cvt_pk_bf16(S[kb][8 * m + 2], S[kb][8 * m + 3]);
                w.z = cvt_pk_bf16(S[kb][8 * m + 4], S[kb][8 * m + 5]); w.w = cvt_pk_bf16(S[kb][8 * m + 6], S[kb][8 * m + 7]); Pf[2 * kb + m] = __builtin_bit_cast(bf16x8, w); }
        u32x2 Vg[4][2];
#pragma unroll
        for (int ck = 0; ck < 4; ++ck) { const bf16_t* vp = Vt + (32 + l31) * VPI; const int sw = (4 + (l31 >> 3)) * 8; Vg[ck][0] = *(const u32x2*)(vp + ((ck * 16 + hi * 4) ^ sw)); Vg[ck][1] = *(const u32x2*)(vp + ((ck * 16 + 8 + hi * 4) ^ sw)); }
#pragma unroll
        for (int ck = 0; ck < 4; ++ck) { u32x4 w; w.x = Vf[ck][0].x; w.y = Vf[ck][0].y; w.z = Vf[ck][1].x; w.w = Vf[ck][1].y;
            O[0] = __builtin_amdgcn_mfma_f32_32x32x16_bf16(__builtin_bit_cast(bf16x8, w), Pf[ck], O[0], 0, 0, 0); }
#pragma unroll
        for (int ck = 0; ck < 4; ++ck) { u32x4 w; w.x = Vg[ck][0].x; w.y = Vg[ck][0].y; w.z = Vg[ck][1].x; w.w = Vg[ck][1].y;
            O[1] = __builtin_amdgcn_mfma_f32_32x32x16_bf16(__builtin_bit_cast(bf16x8, w), Pf[ck], O[1], 0, 0, 0); }
        }
        if (i + 1 < nt) ATT_WRITE((i + 1) & 1);
        __syncthreads();
        if (i + 2 < nt) ATT_PREFETCH(i + 2);
    }
#undef ATT_PREFETCH
#undef ATT_WRITE
    const int ycol = (TYPE == 0 ? 0 : (TYPE == 1 ? 512 : 1536)) + h * 64;
    const float inv = __builtin_amdgcn_rcpf(half_sum(lrun));
    bf16_t* yp = P.Y + (size_t)qrow * 2048 + ycol + hi * 4;
#pragma unroll
    for (int db = 0; db < 2; ++db)
#pragma unroll
        for (int rg = 0; rg < 4; ++rg) { u32x2 w; w.x = cvt_pk_bf16(O[db][4 * rg] * inv, O[db][4 * rg + 1] * inv); w.y = cvt_pk_bf16(O[db][4 * rg + 2] * inv, O[db][4 * rg + 3] * inv);
            *(u32x2*)(yp + db * 32 + rg * 8) = w; }
}
DEV void attn_phase(const int TID, unsigned char* lds, const AttnP& P, int nqt  ) {
    const int total = 3 * 512 + (nqt == 17 ? 96 : 0);
    const int vb = (gridDim.x % 8 == 0) ? (int)((blockIdx.x & 7) * (gridDim.x >> 3) + (blockIdx.x >> 3)) : (int)blockIdx.x;
    for (int it = vb; it < total; it += gridDim.x) {
        int type, b, h, qt;
        if (it < 1536) { type = 2 - (it >> 9); const int r = it & 511; qt = r & 15; h = (r >> 4) & 7; b = r >> 7; }
        else { const int r = it - 1536; type = 2 - r / 32; qt = 16; h = r & 7; b = (r >> 3) & 3; }
        if (type == 2) attn_item<2>(TID, lds, P, b, h, qt); else if (type == 1) attn_item<1>(TID, lds, P, b, h, qt); else attn_item<0>(TID, lds, P, b, h, qt);
    }
    __syncthreads();
}

DEV void mini_tile(const int TID, unsigned char* lds, const bf16_t* Ap, int lda, const bf16_t* Bp, int K, float (&v)[8], const int bstride = 16) {
    const int lane = TID & 63, wid = __builtin_amdgcn_readfirstlane(TID >> 6), fr = lane & 15, fq = lane >> 4;
    const int ksl = K >> 3, k0 = wid * ksl;
    f32x4 acc[4][4];
#pragma unroll
    for (int mb = 0; mb < 4; ++mb)
#pragma unroll
        for (int nb = 0; nb < 4; ++nb) acc[mb][nb] = (f32x4){0.f, 0.f, 0.f, 0.f};
    const bf16_t* ap = Ap + (size_t)fr * lda + k0 + fq * 8; const bf16_t* bp = Bp + (size_t)fr * K + k0 + fq * 8;
#pragma unroll 2
    for (int kk = 0; kk < ksl; kk += 32) {
        bf16x8 a[4], b[4];
#pragma unroll
        for (int i = 0; i < 4; ++i) { a[i] = *(const bf16x8*)(ap + (size_t)(i * 16) * lda + kk); b[i] = *(const bf16x8*)(bp + (size_t)(i * bstride) * K + kk); }
#pragma unroll
        for (int mb = 0; mb < 4; ++mb)
#pragma unroll
            for (int nb = 0; nb < 4; ++nb) acc[mb][nb] = __builtin_amdgcn_mfma_f32_16x16x32_bf16(a[mb], b[nb], acc[mb][nb], 0, 0, 0);
    }
    float* red = (float*)lds;
    __syncthreads();
#pragma unroll
    for (int mb = 0; mb < 4; ++mb)
#pragma unroll
        for (int nb = 0; nb < 4; ++nb)
#pragma unroll
            for (int j = 0; j < 4; ++j) red[wid * 4096 + (mb * 16 + fq * 4 + j) * 64 + nb * 16 + fr] = acc[mb][nb][j];
    __syncthreads();
    const float* rr = red + (TID >> 3) * 64 + (TID & 7) * 8;
    f32x4 s0 = *(const f32x4*)rr, s1 = *(const f32x4*)(rr + 4);
#pragma unroll
    for (int w = 1; w < 8; ++w) { s0 += *(const f32x4*)(rr + w * 4096); s1 += *(const f32x4*)(rr + w * 4096 + 4); }
    v[0] = s0[0]; v[1] = s0[1]; v[2] = s0[2]; v[3] = s0[3]; v[4] = s1[0]; v[5] = s1[1]; v[6] = s1[2]; v[7] = s1[3];
}
DEV void mini_resid(const int TID, unsigned char* lds, const bf16_t* A, int lda, const bf16_t* Bt, int K, const float* inc, float* outc, const float* gate, float s) {
    for (int it = blockIdx.x; it < 256; it += gridDim.x) {
        const int r0 = (it >> 4) * 64, c0 = (it & 15) * 64; float v[8];
        mini_tile(TID, lds, A + (size_t)(M_LAT + r0) * lda, lda, Bt + (size_t)c0 * K, K, v);
        const int row = r0 + (TID >> 3), col = c0 + (TID & 7) * 8; const size_t off = (size_t)row * D + col;
#pragma unroll
        for (int q = 0; q < 2; ++q) { const f32x4 g4 = *(const f32x4*)(gate + col + q * 4) * s, b4 = *(const f32x4*)(inc + off + q * 4);
            f32x4 a4; a4[0] = v[q * 4]; a4[1] = v[q * 4 + 1]; a4[2] = v[q * 4 + 2]; a4[3] = v[q * 4 + 3];
            *(f32x4*)(outc + off + q * 4) = b4 + g4 * a4; }
    }
    __syncthreads();
}
DEV void mini_pgemm(const int TID, unsigned char* lds, const bf16_t* Yb, const bf16_t* Wbr, bf16_t* PBo) {
    for (int it = blockIdx.x; it < 1024; it += gridDim.x) {
        const int r0 = (it >> 6) * 64, c0 = (it & 63) * 64; float v[8];
        mini_tile(TID, lds, Yb + (size_t)(M_LAT + r0) * 2048 + (c0 >> 10) * 512, 2048, Wbr + (size_t)c0 * 512, 512, v);
        const int row = M_LAT + r0 + (TID >> 3), col = c0 + (TID & 7) * 8;
        u32x4 w; w.x = cvt_pk_bf16(v[0], v[1]); w.y = cvt_pk_bf16(v[2], v[3]); w.z = cvt_pk_bf16(v[4], v[5]); w.w = cvt_pk_bf16(v[6], v[7]);
        *(u32x4*)(PBo + (size_t)row * 4096 + col) = w;
    }
    __syncthreads();
}
DEV void mini_merge(const int TID, unsigned char* lds, const bf16_t* XNb, const bf16_t* Wg, const bf16_t* PBi, bf16_t* MBo) {
    for (int it = blockIdx.x; it < 256; it += gridDim.x) {
        const int r0 = (it >> 4) * 64, c0 = (it & 15) * 64;
        const int row = M_LAT + r0 + (TID >> 3), col = c0 + (TID & 7) * 8;
        float R[8];
#pragma unroll
        for (int j = 0; j < 8; ++j) R[j] = 0.f;
#pragma unroll 1
        for (int n = 0; n < 4; ++n) {
            const int bro = (c0 >> 6) * 256 + (n >> 1) * 128 + (n & 1) * 16; float v[8];
            mini_tile(TID, lds, XNb + (size_t)(M_LAT + r0) * D, D, Wg + (size_t)bro * D, D, v, 32);
            const u32x4 pw = *(const u32x4*)(PBi + (size_t)row * 4096 + n * 1024 + col);
            R[0] += bflo(pw.x) * sigmoidf_(v[0]); R[1] += bfhi(pw.x) * sigmoidf_(v[1]); R[2] += bflo(pw.y) * sigmoidf_(v[2]); R[3] += bfhi(pw.y) * sigmoidf_(v[3]);
            R[4] += bflo(pw.z) * sigmoidf_(v[4]); R[5] += bfhi(pw.z) * sigmoidf_(v[5]); R[6] += bflo(pw.w) * sigmoidf_(v[6]); R[7] += bfhi(pw.w) * sigmoidf_(v[7]);
        }
        u32x4 w; w.x = cvt_pk_bf16(R[0], R[1]); w.y = cvt_pk_bf16(R[2], R[3]); w.z = cvt_pk_bf16(R[4], R[5]); w.w = cvt_pk_bf16(R[6], R[7]);
        *(u32x4*)(MBo + (size_t)row * D + col) = w;
    }
    __syncthreads();
}

#define LAS __attribute__((address_space(3)))
#define XB_TMO      128
#define XB_XCNT(j)  (256  + 64 * (j))
#define XB_XSUB(j)  (1280 + 64 * (j))
#define XB_XGEN(j)  (2304 + 64 * (j))
#define XB_TOP      3328
#define XB_TOPGEN   3392
#define XCD_BAR_WORDS 3456
#define XB_SPIN_CAP (1u << 18)

__device__ __forceinline__ unsigned xb_ld(unsigned* p)              { return __hip_atomic_load(p, __ATOMIC_RELAXED, __HIP_MEMORY_SCOPE_AGENT); }
__device__ __forceinline__ unsigned xb_add(unsigned* p, unsigned v) { return __hip_atomic_fetch_add(p, v, __ATOMIC_RELAXED, __HIP_MEMORY_SCOPE_AGENT); }
__device__ __forceinline__ unsigned xb_xcc_id() { return (unsigned)__builtin_amdgcn_s_getreg((3 << 11) | 20) & 0xFu; }
#define XB_SPIN(cond, bar) do { unsigned _sp = 0; while (cond) { __builtin_amdgcn_s_sleep(1); \
    if ((++_sp & 255u) == 0u) { if (xb_ld(&(bar)[XB_TMO])) break; if (_sp > XB_SPIN_CAP) { atomicAdd(&(bar)[XB_TMO], 1u); break; } } } } while (0)

struct XcdBarrier {
    unsigned* bar; unsigned x;
    volatile LAS unsigned* st;
};

__device__ __forceinline__ XcdBarrier xcd_barrier_post(unsigned* bar, volatile LAS unsigned* st) {
    XcdBarrier b; b.bar = bar; b.x = xb_xcc_id(); b.st = st;
    if (threadIdx.x == 0) (void)xb_add(&bar[XB_XCNT(b.x)], 1u);
    return b;
}
__device__ __forceinline__ void xcd_barrier_complete(unsigned* bar, unsigned x, unsigned& nloc, unsigned& nx) {
    const unsigned G = gridDim.x * gridDim.y * gridDim.z;
    unsigned sum, cnt, mine, sp = 0u;
    for (;;) {
        sum = 0u; cnt = 0u; mine = 0u;
#pragma unroll
        for (unsigned j = 0; j < 16; ++j) { const unsigned c = xb_ld(&bar[XB_XCNT(j)]); sum += c; cnt += (c > 0u) ? 1u : 0u; mine = (j == x) ? c : mine; }
        if (sum == G) break;
        __builtin_amdgcn_s_sleep(1);
        if ((++sp & 255u) == 0u) { if (xb_ld(&bar[XB_TMO])) break; if (sp > XB_SPIN_CAP) { atomicAdd(&bar[XB_TMO], 1u); break; } }
    }
    nloc = mine > 0u ? mine : 1u; nx = cnt > 0u ? cnt : 1u;
}

__device__ __forceinline__ void xcd_barrier(const XcdBarrier& b) {
    asm volatile("s_waitcnt vmcnt(0)" ::: "memory");
    __syncthreads();
    if (threadIdx.x == 0) {
        unsigned* bar = b.bar;
        __builtin_amdgcn_s_waitcnt(0);
        unsigned nloc = b.st[0], nx = b.st[1];
        if (nloc == 0u) { xcd_barrier_complete(bar, b.x, nloc, nx); b.st[0] = nloc; b.st[1] = nx; }
        const unsigned old = xb_add(&bar[XB_XSUB(b.x)], 1u);
        const unsigned gen = old / nloc;
        if (old + 1u == (gen + 1u) * nloc) {
            __builtin_amdgcn_fence(__ATOMIC_RELEASE, "agent");
            asm volatile("s_waitcnt vmcnt(0)" ::: "memory");
            const unsigned og = xb_add(&bar[XB_TOP], 1u);
            const unsigned tg = og / nx;
            if (og + 1u == (tg + 1u) * nx) xb_add(&bar[XB_TOPGEN], 1u);
            else XB_SPIN(xb_ld(&bar[XB_TOPGEN]) == tg, bar);
            __builtin_amdgcn_fence(__ATOMIC_ACQUIRE, "agent");
            xb_add(&bar[XB_XGEN(b.x)], 1u);
            asm volatile("s_waitcnt vmcnt(0)" ::: "memory");
        } else {
            XB_SPIN(xb_ld(&bar[XB_XGEN(b.x)]) == gen, bar);
            __builtin_amdgcn_fence(__ATOMIC_ACQUIRE, "agent");
            asm volatile("s_waitcnt vmcnt(0)" ::: "memory");
        }
    }
    __syncthreads();
}

#ifndef PHMASK
#define PHMASK 0xffffffffu
#endif
constexpr int PER_LAYER = 15;
constexpr int N_PHASES = 1 + 2 * PER_LAYER + 1;
__global__ void __launch_bounds__(NTHREADS, 2) fwd_kernel(KP pbyval) {
    extern __shared__ __attribute__((aligned(16))) unsigned char lds[];
    cg::grid_group grid = cg::this_grid();
    KPP p = (KPP)__builtin_amdgcn_kernarg_segment_ptr();
    const int ph_lo = p->ph_lo, ph_hi = p->ph_hi;
    const int wid_s = __builtin_amdgcn_readfirstlane((int)(threadIdx.x >> 6));
    volatile LAS unsigned* bst = (volatile LAS unsigned*)((LAS unsigned char*)lds + (LDS_BYTES - 64));
    if (threadIdx.x < 2) bst[threadIdx.x] = 0u;
    __syncthreads();
    const XcdBarrier xbar = xcd_barrier_post((unsigned*)(p->ws + WS_CTL), bst);
#pragma unroll 1
    for (int ph = ph_lo; ph < ph_hi; ++ph) {
        asm volatile("" : "+s"(p));
        unsigned allm = ~0u; asm volatile("" : "+s"(allm));
        int TID = (wid_s << 6) | (int)__builtin_amdgcn_mbcnt_hi(allm, __builtin_amdgcn_mbcnt_lo(allm, 0u)); asm volatile("" : "+v"(TID));
        int kind, l;
        if (ph < 1) { kind = 0; l = 0; } else if (ph == N_PHASES - 1) { kind = 18; l = 0; } else { l = (ph - 1) / PER_LAYER; kind = 2 + (ph - 1) % PER_LAYER; if (kind >= 9) kind += 1; }
        PG8_LAS unsigned char* ldsl = (PG8_LAS unsigned char*)lds;
        const int G = gridDim.x, cb = blockIdx.x;
        const bool last = (l == 1);
        const int Mpost = last ? M_LAT : M_ALL;
#define MOD ((float*)(p->ws + WS_MOD))
#define HC ((float*)(p->ws + WS_HC))
#define XN ((bf16_t*)(p->ws + WS_XN))
#define Y ((bf16_t*)(p->ws + WS_Y))
#define G5 ((bf16_t*)(p->ws + WS_G5))
#define WA ((bf16_t*)(p->ws + WS_BIG + BIG_WA))
#define MLAQ ((bf16_t*)(p->ws + WS_BIG + BIG_MLAQ))
#define MLAKV ((bf16_t*)(p->ws + WS_BIG + BIG_MLAKV))
#define ACT ((bf16_t*)(p->ws + WS_BIG))
#define PB ((bf16_t*)(p->ws + WS_BIG + BIG_P))
#define MB ((bf16_t*)(p->ws + WS_BIG + BIG_MB))
#define wb (p->ws + WS_WB)
#define modl (MOD + (size_t)l * 5 * 9 * 1024)
#define KIND(k) (((PHMASK >> (k)) & 1u) && kind == (k))
        if (KIND(0)) { modp_phase(TID, p, lds); wprep_phase(TID, p, lds, 0, 0); }
        else if (KIND(2)) { const float* hlat = (l == 0) ? p->in[0] : p->out; const float* hctx = (l == 0) ? p->in[2] : HC;
            norm_phase(TID, p, hlat, hctx, p->in[6] + l * D, modl, 0, M_ALL); if (l == 1) wprep_phase(TID, p, lds, 1, 0); }
        else if (KIND(3)) { pg8::Gemm g{XN, D, (const bf16_t*)(wb + WB_GU), M_ALL, 5632, D, 0, 0}; pg8::StaticOrder S; S.init(M_ALL, 5632, G, cb); EpiSwiglu E{ACT};
            pg8::gemm_phase<EpiSwiglu, pg8::StaticOrder, true, true>(TID, ldsl, g, S, E); }
        else if (KIND(4)) { const float* hlat = (l == 0) ? p->in[0] : p->out; const float* hctx = (l == 0) ? p->in[2] : HC;
            pg8::Gemm g{ACT, DFF, (const bf16_t*)(wb + WB_DN), M_LAT, D, DFF, 0, 0}; pg8::StaticOrder S; S.init(M_LAT, D, G, cb);
            EpiResid E{hlat, hctx, p->out, HC, modl + 2 * 1024, 0.5f};
            pg8::gemm_phase<EpiResid, pg8::StaticOrder, true, true>(TID, ldsl, g, S, E);
            mini_resid(TID, lds, ACT, DFF, (const bf16_t*)(wb + WB_DN), DFF, hctx, HC, modl + (size_t)(4 * 9 + 2) * 1024, 0.5f); }
        else if (KIND(5)) { norm_phase(TID, p, p->out, HC, p->in[10] + l * D, modl, 3, M_ALL); }
        else if (KIND(6)) { pg8::Gemm g{XN, D, (const bf16_t*)(wb + WB_INA), M_ALL, WA_N, D, 0, 0}; pg8::StaticOrder S; S.init(M_ALL, WA_N, G, cb); EpiStore E{WA, WA_N};
            pg8::gemm_phase<EpiStore, pg8::StaticOrder, true, true>(TID, ldsl, g, S, E);
            S5L L5{p->in[14] + l * 4096, p->in[15] + l * 4096, p->in[16] + l * 64, p->in[17] + (size_t)l * 65536, p->in[18] + (size_t)l * 65536,
                   p->in[19] + (size_t)l * 65536, p->in[20] + (size_t)l * 65536, p->in[21] + l * 512};
            const int nfull = (M_ALL / 256) * (WA_N / 256) - 3 * G;
            if (nfull > 0 && nfull < G) s5_pre_phase(TID, p, L5, lds, nfull, G - nfull); else s5_pre_phase(TID, p, L5, lds, 0, G); }
        else if (KIND(7) || KIND(8) || KIND(10)) {
            S5L L5{p->in[14] + l * 4096, p->in[15] + l * 4096, p->in[16] + l * 64, p->in[17] + (size_t)l * 65536, p->in[18] + (size_t)l * 65536,
                   p->in[19] + (size_t)l * 65536, p->in[20] + (size_t)l * 65536, p->in[21] + l * 512};
            if (kind == 7) { mlanorm_phase(TID, p, p->in[24] + l * 256, p->in[26] + l * 128); s5_local_phase(TID, p, L5); }
            else if (kind == 8) { s5_carry_phase(TID, p, L5);
                pg8::Gemm g{WA + C_CQ, WA_N, (const bf16_t*)(wb + WB_UQ), M_ALL, 768, 256, 0, 0}; pg8::StaticOrder S; S.init(M_ALL, 768, G, cb); EpiStore E{MLAQ, 768};
                pg8::gemm_phase<EpiStore, pg8::StaticOrder, true, true>(TID, ldsl, g, S, E);
                pg8::Gemm g2{WA + C_CKV, WA_N, (const bf16_t*)(wb + WB_UKV), M_ALL, 1024, 128, 0, 0}; pg8::StaticOrder S2; S2.init(M_ALL, 1024, G, cb); EpiStore E2{MLAKV, 1024};
                pg8::gemm_phase<EpiStore, pg8::StaticOrder, true, true>(TID, ldsl, g2, S2, E2); }
            else { AttnP AP{WA, MLAQ, MLAKV, Y, p->in[12] + l * 3720, p->in[13] + l * 8}; attn_phase(TID, lds, AP, last ? 16 : 17);
                s5_out_phase(TID, p, L5, last); }
        }
        else if (KIND(11)) { pg8::Gemm g{G5, 512, (const bf16_t*)(wb + WB_GLU), Mpost, 512, 512, 0, 0}; pg8::StaticOrder S; S.init(Mpost, 512, G, cb); EpiGlu E{G5, p->in[23] + l * 512, Y};
            pg8::gemm_phase<EpiGlu, pg8::StaticOrder, true, true>(TID, ldsl, g, S, E); wprep_phase(TID, p, lds, l, 1); }
        else if (KIND(12)) { pg8::Gemm g{Y, 2048, (const bf16_t*)(wb + WB_BR), M_LAT, 4096, 512, 4, 512}; pg8::StaticOrder S; S.init(M_LAT, 4096, G, cb); EpiStore E{PB, 4096};
            pg8::gemm_phase<EpiStore, pg8::StaticOrder, true, true>(TID, ldsl, g, S, E);
            if (!last) mini_pgemm(TID, lds, Y, (const bf16_t*)(wb + WB_BR), PB); }
        else if (KIND(13)) { pg8::Gemm g{XN, D, (const bf16_t*)(wb + WB_G), M_LAT, 4096, D, 0, 0}; pg8::StaticOrder S; S.init(M_LAT, 4096, G, cb); EpiMerge E{PB, MB};
            pg8::gemm_phase<EpiMerge, pg8::StaticOrder, true, true>(TID, ldsl, g, S, E);
            if (!last) mini_merge(TID, lds, XN, (const bf16_t*)(wb + WB_G), PB, MB); }
        else if (KIND(14)) { pg8::Gemm g{MB, D, (const bf16_t*)(wb + WB_OUT), M_LAT, D, D, 0, 0}; pg8::StaticOrder S; S.init(M_LAT, D, G, cb);
            EpiResid E{p->out, HC, p->out, HC, modl + 5 * 1024, 1.0f};
            pg8::gemm_phase<EpiResid, pg8::StaticOrder, true, true>(TID, ldsl, g, S, E);
            if (!last) mini_resid(TID, lds, MB, D, (const bf16_t*)(wb + WB_OUT), D, HC, HC, modl + (size_t)(4 * 9 + 5) * 1024, 1.0f); }
        else if (KIND(15)) { norm_phase(TID, p, p->out, HC, p->in[30] + l * D, modl, 6, Mpost); }
        else if (KIND(16)) { pg8::Gemm g{XN, D, (const bf16_t*)(wb + WB_GU), Mpost, 5632, D, 0, 0}; pg8::StaticOrder S; S.init(Mpost, 5632, G, cb); EpiSwiglu E{ACT};
            pg8::gemm_phase<EpiSwiglu, pg8::StaticOrder, true, true>(TID, ldsl, g, S, E); }
        else if (KIND(17)) { pg8::Gemm g{ACT, DFF, (const bf16_t*)(wb + WB_DN), M_LAT, D, DFF, 0, 0}; pg8::StaticOrder S; S.init(M_LAT, D, G, cb);
            EpiResid E{p->out, HC, p->out, HC, modl + 8 * 1024, 0.5f};
            pg8::gemm_phase<EpiResid, pg8::StaticOrder, true, true>(TID, ldsl, g, S, E);
            if (!last) mini_resid(TID, lds, ACT, DFF, (const bf16_t*)(wb + WB_DN), DFF, HC, HC, modl + (size_t)(4 * 9 + 8) * 1024, 0.5f); }
        else if (KIND(18)) { final_phase(TID, p); }
#undef KIND
#undef MOD
#undef HC
#undef XN
#undef Y
#undef G5
#undef WA
#undef MLAQ
#undef MLAKV
#undef ACT
#undef PB
#undef MB
#undef wb
#undef modl
        if (ph + 1 < ph_hi) { if (ph_lo < 0) grid.sync(); else xcd_barrier(xbar); }
    }
}

extern "C" void kernel_launch(void* const* d_in, const int* in_sizes, int n_in, void* d_out, int out_size, void* d_ws, size_t ws_size, hipStream_t stream) {
    static int grid = 0;
    if (grid == 0) {
        if (n_in != 35 || out_size != M_LAT * D || ws_size < WS_END) { fprintf(stderr, "kernel_launch: unexpected shapes (n_in %d out %d ws %zu need %zu)\n", n_in, out_size, ws_size, (size_t)WS_END); grid = -1; return; }
        int dev = 0, cus = 0, per_cu = 0;
        hipGetDevice(&dev); hipDeviceGetAttribute(&cus, hipDeviceAttributeMultiprocessorCount, dev);
        if (hipFuncSetAttribute((const void*)fwd_kernel, hipFuncAttributeMaxDynamicSharedMemorySize, LDS_BYTES) != hipSuccess) { fprintf(stderr, "kernel_launch: hipFuncSetAttribute failed\n"); grid = -1; return; }
        if (hipOccupancyMaxActiveBlocksPerMultiprocessor(&per_cu, (const void*)fwd_kernel, NTHREADS, LDS_BYTES) != hipSuccess || per_cu < 1) { fprintf(stderr, "kernel_launch: occupancy query failed (%d)\n", per_cu); (void)hipGetLastError(); per_cu = 1; }
        grid = cus * 1;
        if (grid < 8) grid = 8;
    }
    if (grid < 0) return;
    if (hipMemsetAsync((char*)d_ws, 0, WS_CTL + CTL_BYTES, stream) != hipSuccess) { fprintf(stderr, "kernel_launch: memset failed\n"); return; }
    KP a{};
    for (int i = 0; i < 35; ++i) a.in[i] = (const float*)d_in[i];
    a.out = (float*)d_out; a.ws = (unsigned char*)d_ws; a.ph_lo = 0; a.ph_hi = N_PHASES;
    void* args[] = {&a};
    hipError_t e = hipLaunchCooperativeKernel((const void*)fwd_kernel, dim3(grid), dim3(NTHREADS), args, LDS_BYTES, stream);
    if (e != hipSuccess) fprintf(stderr, "cooperative launch failed: %s (grid %d)\n", hipGetErrorString(e), grid);
}
```

```cpp
#include <hip/hip_runtime.h>
#include <hip/hip_cooperative_groups.h>
#include <cstdio>
#include <cstdint>
namespace cg = cooperative_groups;

namespace pg8 {
#define PG8_LAS __attribute__((address_space(3)))
typedef unsigned short bf16_t;
typedef short bf16x8 __attribute__((ext_vector_type(8)));
typedef short s16x4 __attribute__((ext_vector_type(4)));
typedef float f32x4 __attribute__((ext_vector_type(4)));
typedef unsigned u32x4 __attribute__((ext_vector_type(4)));
typedef unsigned u32x2 __attribute__((ext_vector_type(2)));
constexpr int BM = 256, BK = 64, HALF = 128, HTB = HALF * BK * 2, STAGE_BYTES = 8 * HTB, NXCD = 8, WGM = 8;

__host__ __device__ __forceinline__ int lds_byte(int r, int c) { const int st = (r >> 4) * 2 + (c >> 5), rr = r & 15, cc = c & 31, ob = rr * 64 + cc * 2; return st * 1024 + (ob ^ (((ob >> 9) & 1) << 5)); }
__host__ __device__ __forceinline__ void stage_rc(int b, int& R, int& C) { const int st = b / 1024, sb = b % 1024, swz = sb ^ (((sb >> 9) & 1) << 5); R = (st >> 1) * 16 + swz / 64; C = (st & 1) * 32 + (swz % 64) / 2; }

__host__ __device__ __forceinline__ int perm32(int rho) { const int n = rho >> 4, i = rho & 15; return 8 * (i >> 2) + 4 * n + (i & 3); }
struct Unit { int pm, pn; };
struct Gemm { const bf16_t* A; int lda; const bf16_t* Bt; int M, N, K; int a_div; int a_stride; };

struct StaticOrder {
    int nM, nN, nwg, G, c;
    __host__ __device__ void init(int M, int N, int G_, int c_) { nM = M / BM; nN = N / BM; nwg = nM * nN; G = G_; c = c_; }
    __host__ __device__ bool next(int i, Unit& u) const {
        const long L = (long)i * G + c; if (L >= nwg) return false;
        int wgid = (int)L; { const int q = nwg / NXCD, r = nwg % NXCD, xcd = wgid % NXCD, off = wgid / NXCD; wgid = (xcd < r ? xcd * (q + 1) : r * (q + 1) + (xcd - r) * q) + off; }
        const int nig = WGM * nN, gid = wgid / nig, fm = gid * WGM, gsz = (nM - fm) < WGM ? (nM - fm) : WGM;
        u.pm = fm + ((wgid % nig) % gsz); u.pn = (wgid % nig) / gsz; return true;
    }
};
__device__ __forceinline__ unsigned cvt_pk_bf16(float lo, float hi) { unsigned r; asm volatile("v_cvt_pk_bf16_f32 %0, %1, %2" : "=v"(r) : "v"(lo), "v"(hi)); return r; }

template <class Epi, class Sched, bool ALIGN_EPI = false, bool SP2 = false>
__device__ __forceinline__ void gemm_phase(const int TID, PG8_LAS unsigned char* lds, const Gemm g, const Sched& S, const Epi& E) {
    const int tid = TID, wid = __builtin_amdgcn_readfirstlane(tid >> 6), lane = tid & 63, wr = wid >> 2, wc = wid & 3, fr = lane & 15, fq = lane >> 4;
    int K = g.K, lda = g.lda; asm volatile("" : "+s"(K), "+s"(lda));
    const int nt = K / BK;
    unsigned voffA[2], voffB[2];
#pragma unroll
    for (int i = 0; i < 2; ++i) { int R, C; stage_rc(tid * 16 + i * 8192, R, C);
        const int Rb = Epi::PERM ? ((R & ~31) + perm32(R & 31)) : R;
        voffA[i] = (unsigned)(R * lda + C) * 2u; voffB[i] = (unsigned)(Rb * K + C) * 2u; }
    const size_t kstep = (size_t)(BK * 2);
    const size_t hstepA = (size_t)HALF * lda * 2, hstepB = (size_t)HALF * K * 2;
    const size_t tstepA = 2 * hstepA, tstepB = 2 * hstepB;
    const unsigned ldsw = (unsigned)wid * 1024u;
    const int aoff = lds_byte(wr * 64 + fr, fq * 8), boff = lds_byte(wc * 32 + fr, fq * 8);
#define PG8_ABASE(u) ((const char*)g.A + (size_t)(u).pm * tstepA + (g.a_div ? (size_t)((u).pn / g.a_div) * (size_t)g.a_stride * 2 : (size_t)0))
#define PG8_SA(b, h) (((b) * 2 + (h)) * HTB)
#define PG8_SB(b, h) ((4 + (b) * 2 + (h)) * HTB)
#define PG8_STAGE(bufoff, gbase, voff) do { _Pragma("unroll") for (int _i = 0; _i < 2; ++_i) \
        __builtin_amdgcn_global_load_lds((const unsigned*)((const char*)(gbase) + (voff)[_i]), (PG8_LAS unsigned*)(lds + (bufoff) + ldsw + _i * 8192), 16, 0, 0); } while (0)
#define PG8_LDA(dst, b, h) do { _Pragma("unroll") for (int m = 0; m < 4; ++m) _Pragma("unroll") for (int k = 0; k < 2; ++k) dst[m][k] = *(const PG8_LAS bf16x8*)(lds + PG8_SA(b, h) + aoff + m * 2048 + k * 1024); } while (0)
#define PG8_LDB(dst, b, h) do { _Pragma("unroll") for (int n = 0; n < 2; ++n) _Pragma("unroll") for (int k = 0; k < 2; ++k) dst[n][k] = *(const PG8_LAS bf16x8*)(lds + PG8_SB(b, h) + boff + n * 2048 + k * 1024); } while (0)
#define PG8_MMA(ai, bj, At, Bt) do { __builtin_amdgcn_s_setprio(1); _Pragma("unroll") for (int m = 0; m < 4; ++m) _Pragma("unroll") for (int n = 0; n < 2; ++n) _Pragma("unroll") for (int k = 0; k < 2; ++k) \
        acc[ai][bj][m][n] = __builtin_amdgcn_mfma_f32_16x16x32_bf16(Bt[n][k], At[m][k], acc[ai][bj][m][n], 0, 0, 0); __builtin_amdgcn_s_setprio(0); } while (0)
#define PG8_WAIT_V(n) asm volatile("s_waitcnt vmcnt(" #n ")" ::: "memory")
#define PG8_WAIT_L(n) asm volatile("s_waitcnt lgkmcnt(" #n ")" ::: "memory")
#define PG8_BAR __builtin_amdgcn_s_barrier()
#define PG8_SCHED __builtin_amdgcn_sched_barrier(0)
    Unit cur, nxt; int ui = 0;
    if (!S.next(0, cur)) return;
    f32x4 acc[2][2][4][2];
#pragma unroll
    for (int a = 0; a < 2; ++a)
#pragma unroll
        for (int b = 0; b < 2; ++b)
#pragma unroll
            for (int m = 0; m < 4; ++m)
#pragma unroll
                for (int n = 0; n < 2; ++n) acc[a][b][m][n] = (f32x4){0.f, 0.f, 0.f, 0.f};
    bf16x8 At[4][2], B0[2][2], B1[2][2];
    const char* cA = PG8_ABASE(cur); const char* cB = (const char*)g.Bt + (size_t)cur.pn * tstepB;
    if constexpr (SP2) {
        PG8_STAGE(PG8_SB(0, 0), cB, voffB); PG8_STAGE(PG8_SB(0, 1), cB + hstepB, voffB); PG8_STAGE(PG8_SA(0, 0), cA, voffA); PG8_STAGE(PG8_SA(0, 1), cA + hstepA, voffA);
        if (wr == 1) PG8_BAR;
        PG8_WAIT_V(2); PG8_BAR;
        PG8_STAGE(PG8_SB(1, 0), cB + kstep, voffB); PG8_STAGE(PG8_SA(1, 0), cA + kstep, voffA); PG8_STAGE(PG8_SB(1, 1), cB + hstepB + kstep, voffB);
        PG8_WAIT_V(6); PG8_BAR;
    } else {
        PG8_STAGE(PG8_SB(0, 0), cB, voffB); PG8_STAGE(PG8_SA(0, 0), cA, voffA); PG8_STAGE(PG8_SB(0, 1), cB + hstepB, voffB); PG8_STAGE(PG8_SA(0, 1), cA + hstepA, voffA);
        if (wr == 1) PG8_BAR;
        PG8_WAIT_V(4); PG8_BAR;
        PG8_STAGE(PG8_SB(1, 0), cB + kstep, voffB); PG8_STAGE(PG8_SA(1, 0), cA + kstep, voffA); PG8_STAGE(PG8_SB(1, 1), cB + hstepB + kstep, voffB);
        PG8_WAIT_V(6); PG8_BAR;
    }
    for (;;) {
        const bool has_next = S.next(ui + 1, nxt);
        const char* nA = has_next ? PG8_ABASE(nxt) : cA; const char* nB = has_next ? (const char*)g.Bt + (size_t)nxt.pn * tstepB : cB;
        for (int t = 0; t < nt; t += 2) {
            const bool last = (t == nt - 2);
            const char* a1 = cA + (size_t)(t + 1) * kstep;
            const char* a2 = last ? nA : cA + (size_t)(t + 2) * kstep; const char* b2 = last ? nB : cB + (size_t)(t + 2) * kstep;
            const char* a3 = a2 + kstep; const char* b3 = b2 + kstep;
            if constexpr (SP2) {
            PG8_LDB(B0, 0, 0); PG8_LDB(B1, 0, 1); PG8_SCHED; PG8_LDA(At, 0, 0); PG8_STAGE(PG8_SA(1, 1), a1 + hstepA, voffA);
            PG8_WAIT_V(8); PG8_WAIT_L(0); PG8_BAR; PG8_MMA(0, 0, At, B0); PG8_MMA(0, 1, At, B1); PG8_BAR; PG8_SCHED;
            PG8_LDA(At, 0, 1); PG8_STAGE(PG8_SB(0, 0), b2, voffB); PG8_STAGE(PG8_SB(0, 1), b2 + hstepB, voffB); PG8_STAGE(PG8_SA(0, 0), a2, voffA);
            PG8_WAIT_V(8); PG8_WAIT_L(0); PG8_BAR; PG8_MMA(1, 0, At, B0); PG8_MMA(1, 1, At, B1); PG8_BAR; PG8_SCHED;
            PG8_LDB(B0, 1, 0); PG8_LDB(B1, 1, 1); PG8_SCHED; PG8_LDA(At, 1, 0); PG8_STAGE(PG8_SA(0, 1), a2 + hstepA, voffA);
            PG8_WAIT_V(8); PG8_WAIT_L(0); PG8_BAR; PG8_MMA(0, 0, At, B0); PG8_MMA(0, 1, At, B1); PG8_BAR; PG8_SCHED;
            PG8_LDA(At, 1, 1); PG8_STAGE(PG8_SB(1, 0), b3, voffB); PG8_STAGE(PG8_SB(1, 1), b3 + hstepB, voffB); PG8_STAGE(PG8_SA(1, 0), a3, voffA);
            PG8_WAIT_V(8); PG8_WAIT_L(0); PG8_BAR; PG8_MMA(1, 0, At, B0); PG8_MMA(1, 1, At, B1); PG8_BAR; PG8_SCHED;
            } else {
            PG8_LDB(B0, 0, 0); PG8_SCHED; PG8_LDA(At, 0, 0); PG8_STAGE(PG8_SA(1, 1), a1 + hstepA, voffA);
            PG8_WAIT_L(8); PG8_BAR; PG8_WAIT_L(0); PG8_MMA(0, 0, At, B0); PG8_BAR; PG8_SCHED;
            PG8_LDB(B1, 0, 1); PG8_STAGE(PG8_SB(0, 0), b2, voffB);
            PG8_BAR; PG8_WAIT_L(0); PG8_MMA(0, 1, At, B1); PG8_BAR;
            PG8_LDA(At, 0, 1); PG8_STAGE(PG8_SA(0, 0), a2, voffA);
            PG8_BAR; PG8_WAIT_L(0); PG8_MMA(1, 0, At, B0); PG8_BAR; PG8_SCHED;
            PG8_STAGE(PG8_SB(0, 1), b2 + hstepB, voffB);
            PG8_WAIT_V(6); PG8_BAR; PG8_MMA(1, 1, At, B1); PG8_BAR;
            PG8_LDB(B0, 1, 0); PG8_SCHED; PG8_LDA(At, 1, 0); PG8_STAGE(PG8_SA(0, 1), a2 + hstepA, voffA);
            PG8_WAIT_L(8); PG8_BAR; PG8_WAIT_L(0); PG8_MMA(0, 0, At, B0); PG8_BAR; PG8_SCHED;
            PG8_LDB(B1, 1, 1); PG8_STAGE(PG8_SB(1, 0), b3, voffB);
            PG8_BAR; PG8_WAIT_L(0); PG8_MMA(0, 1, At, B1); PG8_BAR;
            PG8_LDA(At, 1, 1); PG8_STAGE(PG8_SA(1, 0), a3, voffA);
            PG8_BAR; PG8_WAIT_L(0); PG8_MMA(1, 0, At, B0); PG8_BAR; PG8_SCHED;
            PG8_STAGE(PG8_SB(1, 1), b3 + hstepB, voffB);
            PG8_WAIT_V(6); PG8_BAR; PG8_MMA(1, 1, At, B1); PG8_BAR;
            }
        }
        if constexpr (ALIGN_EPI) { if (wr == 0) PG8_BAR; }
        E(acc, cur, wr, wc, fr, fq);
        if (!has_next) break;
#pragma unroll
        for (int a = 0; a < 2; ++a)
#pragma unroll
            for (int b = 0; b < 2; ++b)
#pragma unroll
                for (int m = 0; m < 4; ++m)
#pragma unroll
                    for (int n = 0; n < 2; ++n) acc[a][b][m][n] = (f32x4){0.f, 0.f, 0.f, 0.f};
        cur = nxt; cA = nA; cB = nB; ++ui;
        if constexpr (ALIGN_EPI) { if (wr == 1) PG8_BAR; }
    }
    PG8_WAIT_V(0);
    if constexpr (!ALIGN_EPI) { if (wr == 0) PG8_BAR; }
    PG8_BAR;
#undef PG8_ABASE
#undef PG8_SA
#undef PG8_SB
#undef PG8_STAGE
#undef PG8_LDA
#undef PG8_LDB
#undef PG8_MMA
#undef PG8_WAIT_V
#undef PG8_WAIT_L
#undef PG8_BAR
#undef PG8_SCHED
}
}

using pg8::bf16_t; using pg8::bf16x8; using pg8::s16x4; using pg8::f32x4; using pg8::u32x4; using pg8::u32x2; using pg8::cvt_pk_bf16; using pg8::Unit;

constexpr int D = 1024, BATCH = 4, SEQ = 4096, CTX = 256, DFF = 2816, NMOD = 9;
constexpr int M_LAT = BATCH * SEQ, M_ALL = M_LAT + BATCH * CTX;
constexpr int WA_N = 3328, INCOLS = 7328;
constexpr int C_NAQ = 0, C_NAK = 512, C_NAV = 1024, C_SWQ = 1536, C_SWK = 2048, C_SWV = 2176, C_S5U = 2304, C_CQ = 2816, C_CKV = 3072, C_KR = 3200;
constexpr float EPS = 1e-6f, LOG2E = 1.4426950408889634f;
constexpr int NTHREADS = 512, NWAVES = 8;
constexpr int LDS_BYTES = 147456;

constexpr size_t MiB = 1u << 20;
constexpr size_t WS_MOD = 0;
constexpr size_t WS_CTL = 512 * 1024, CTL_BYTES = 16384;
constexpr size_t WS_HC = 1 * MiB;
constexpr size_t WS_S5 = 5 * MiB;
constexpr size_t WS_WB = 14 * MiB;
constexpr size_t WB_GU = 0, WB_DN = 11 * MiB, WB_INA = WB_DN + 5632 * 1024, WB_G = WB_INA + 6656 * 1024, WB_UQ = WB_G + 8 * MiB,
                 WB_UKV = WB_UQ + 384 * 1024, WB_BR = WB_UKV + 256 * 1024, WB_OUT = WB_BR + 4 * MiB, WB_GLU = WB_OUT + 2 * MiB, WB_END = WB_GLU + 512 * 1024;
static_assert(WB_END <= 39 * MiB, "weights");
constexpr size_t WS_G5 = 53 * MiB;
constexpr size_t WS_XN = 70 * MiB;
constexpr size_t WS_Y = 104 * MiB;
constexpr size_t WS_BIG = 172 * MiB;
constexpr size_t BIG_WA = 0, BIG_MLAQ = (size_t)M_ALL * WA_N * 2, BIG_MLAKV = BIG_MLAQ + (size_t)M_ALL * 768 * 2, BIG_END = BIG_MLAKV + (size_t)M_ALL * 1024 * 2;
constexpr size_t BIG_P = 0, BIG_MB = (size_t)M_ALL * 4096 * 2;
static_assert(BIG_MB + (size_t)M_ALL * 1024 * 2 <= BIG_END, "overlay");
constexpr size_t WS_KERN = WS_BIG + BIG_END;
constexpr size_t WS_SBH = WS_KERN + 2 * MiB;
constexpr size_t WS_END = WS_SBH + 5 * MiB;
constexpr int KSPLIT = 16;

#define DEV __device__ __forceinline__
DEV float bf2f(unsigned short v) { return __uint_as_float((unsigned)v << 16); }
DEV float bflo(unsigned v) { return __uint_as_float(v << 16); }
DEV float bfhi(unsigned v) { return __uint_as_float(v & 0xffff0000u); }
DEV unsigned short f2bf(float f) { return (unsigned short)(cvt_pk_bf16(f, 0.f) & 0xffffu); }
DEV float sigmoidf_(float x) { return __builtin_amdgcn_rcpf(1.f + __expf(-x)); }
DEV float shflx(float v, int lane, int m) { return __int_as_float(__builtin_amdgcn_ds_bpermute((lane ^ m) << 2, __float_as_int(v))); }
DEV float wave_sum(float v, int lane) {
#pragma unroll
    for (int o = 1; o < 64; o <<= 1) v += shflx(v, lane, o);
    return v;
}
DEV int clampi(int v, int lo, int hi) { return v < lo ? lo : (v > hi ? hi : v); }

struct KP {
    const float* in[35];
    float* out; unsigned char* ws;
    int ph_lo, ph_hi;
};
typedef const __attribute__((address_space(4))) KP* KPP;

struct EpiSwiglu {
    static constexpr bool PERM = true;
    bf16_t* O;
    DEV void operator()(const f32x4 (&acc)[2][2][4][2], const Unit& u, int wr, int wc, int fr, int fq) const {
#pragma unroll
        for (int ai = 0; ai < 2; ++ai)
#pragma unroll
            for (int m = 0; m < 4; ++m) {
                const int row = u.pm * 256 + ai * 128 + wr * 64 + m * 16 + fr;
                float v[8];
#pragma unroll
                for (int n = 0; n < 2; ++n) { const f32x4 g = acc[ai][0][m][n], up = acc[ai][1][m][n];
#pragma unroll
                    for (int j = 0; j < 4; ++j) v[n * 4 + j] = g[j] * sigmoidf_(g[j]) * up[j]; }
                u32x4 w; w.x = cvt_pk_bf16(v[0], v[1]); w.y = cvt_pk_bf16(v[2], v[3]); w.z = cvt_pk_bf16(v[4], v[5]); w.w = cvt_pk_bf16(v[6], v[7]);
                *(u32x4*)(O + (size_t)row * DFF + u.pn * 128 + wc * 32 + fq * 8) = w;
            }
    }
};
struct EpiResid {
    static constexpr bool PERM = false;
    const float* in_lat; const float* in_ctx; float* out_lat; float* out_ctx; const float* gate;   float s;
    DEV void operator()(const f32x4 (&acc)[2][2][4][2], const Unit& u, int wr, int wc, int fr, int fq) const {
        const bool lat = u.pm < 64; const int v = lat ? (u.pm >> 4) : 4;
        const float* gv = gate + (size_t)v * 9 * 1024;
        const float* ib = lat ? in_lat : in_ctx - (size_t)M_LAT * D; float* ob = lat ? out_lat : out_ctx - (size_t)M_LAT * D;
#pragma unroll
        for (int bj = 0; bj < 2; ++bj) {
            const int col = u.pn * 256 + bj * 128 + wc * 32 + fq * 4;
            const f32x4 g0 = *(const f32x4*)(gv + col) * s, g1 = *(const f32x4*)(gv + col + 16) * s;
#pragma unroll
            for (int ai = 0; ai < 2; ++ai) {
                f32x4 b4[4][2];
#pragma unroll
                for (int m = 0; m < 4; ++m) { const float* rp = ib + (size_t)(u.pm * 256 + ai * 128 + wr * 64 + m * 16 + fr) * D + col; b4[m][0] = *(const f32x4*)rp; b4[m][1] = *(const f32x4*)(rp + 16); }
                __builtin_amdgcn_sched_barrier(0);
#pragma unroll
                for (int m = 0; m < 4; ++m) { float* wp = ob + (size_t)(u.pm * 256 + ai * 128 + wr * 64 + m * 16 + fr) * D + col;
                    *(f32x4*)wp = b4[m][0] + g0 * acc[ai][bj][m][0]; *(f32x4*)(wp + 16) = b4[m][1] + g1 * acc[ai][bj][m][1]; }
            }
        }
    }
};
struct EpiStore {
    static constexpr bool PERM = true;
    bf16_t* O; int ldc;
    DEV void operator()(const f32x4 (&acc)[2][2][4][2], const Unit& u, int wr, int wc, int fr, int fq) const {
#pragma unroll
        for (int ai = 0; ai < 2; ++ai)
#pragma unroll
            for (int m = 0; m < 4; ++m) {
                bf16_t* rp = O + (size_t)(u.pm * 256 + ai * 128 + wr * 64 + m * 16 + fr) * ldc + u.pn * 256 + wc * 32 + fq * 8;
#pragma unroll
                for (int bj = 0; bj < 2; ++bj) { const f32x4 v0 = acc[ai][bj][m][0], v1 = acc[ai][bj][m][1];
                    u32x4 w; w.x = cvt_pk_bf16(v0[0], v0[1]); w.y = cvt_pk_bf16(v0[2], v0[3]); w.z = cvt_pk_bf16(v1[0], v1[1]); w.w = cvt_pk_bf16(v1[2], v1[3]);
                    *(u32x4*)(rp + bj * 128) = w; }
            }
    }
};
struct EpiGlu {
    static constexpr bool PERM = true;
    const bf16_t* G5; const float* bias; bf16_t* Y;
    DEV void operator()(const f32x4 (&acc)[2][2][4][2], const Unit& u, int wr, int wc, int fr, int fq) const {
#pragma unroll
        for (int bj = 0; bj < 2; ++bj) {
            const int col = u.pn * 256 + bj * 128 + wc * 32 + fq * 8;
            const f32x4 b0 = *(const f32x4*)(bias + col), b1 = *(const f32x4*)(bias + col + 4);
            u32x4 gw[2][4];
#pragma unroll
            for (int ai = 0; ai < 2; ++ai)
#pragma unroll
                for (int m = 0; m < 4; ++m) gw[ai][m] = *(const u32x4*)(G5 + (size_t)(u.pm * 256 + ai * 128 + wr * 64 + m * 16 + fr) * 512 + col);
            __builtin_amdgcn_sched_barrier(0);
#pragma unroll
            for (int ai = 0; ai < 2; ++ai)
#pragma unroll
                for (int m = 0; m < 4; ++m) {
                    const int row = u.pm * 256 + ai * 128 + wr * 64 + m * 16 + fr;
                    const u32x4 g = gw[ai][m];
                    const f32x4 a0 = acc[ai][bj][m][0] + b0, a1 = acc[ai][bj][m][1] + b1;
                    u32x4 w;
                    w.x = cvt_pk_bf16(bflo(g.x) * sigmoidf_(a0[0]), bfhi(g.x) * sigmoidf_(a0[1])); w.y = cvt_pk_bf16(bflo(g.y) * sigmoidf_(a0[2]), bfhi(g.y) * sigmoidf_(a0[3]));
                    w.z = cvt_pk_bf16(bflo(g.z) * sigmoidf_(a1[0]), bfhi(g.z) * sigmoidf_(a1[1])); w.w = cvt_pk_bf16(bflo(g.w) * sigmoidf_(a1[2]), bfhi(g.w) * sigmoidf_(a1[3]));
                    *(u32x4*)(Y + (size_t)row * 2048 + 1024 + col) = w;
                }
        }
    }
};
struct EpiMerge {
    static constexpr bool PERM = false;
    const bf16_t* P; bf16_t* MB;
    DEV void operator()(const f32x4 (&acc)[2][2][4][2], const Unit& u, int wr, int wc, int fr, int fq) const {
        const int c = u.pn * 64 + wc * 16 + fq * 4;
#pragma unroll
        for (int ai = 0; ai < 2; ++ai) {
            u32x2 pw[4][4];
#pragma unroll
            for (int m = 0; m < 4; ++m) { const bf16_t* pr = P + (size_t)(u.pm * 256 + ai * 128 + wr * 64 + m * 16 + fr) * 4096 + c;
#pragma unroll
                for (int q = 0; q < 4; ++q) pw[m][q] = *(const u32x2*)(pr + q * 1024); }
            __builtin_amdgcn_sched_barrier(0);
#pragma unroll
            for (int m = 0; m < 4; ++m) {
                const int row = u.pm * 256 + ai * 128 + wr * 64 + m * 16 + fr;
                f32x4 v = (f32x4){0.f, 0.f, 0.f, 0.f};
#pragma unroll
                for (int bj = 0; bj < 2; ++bj)
#pragma unroll
                    for (int n = 0; n < 2; ++n) {
                        const u32x2 w2 = pw[m][2 * bj + n]; const f32x4 a4 = acc[ai][bj][m][n];
                        v[0] += bflo(w2.x) * sigmoidf_(a4[0]); v[1] += bfhi(w2.x) * sigmoidf_(a4[1]); v[2] += bflo(w2.y) * sigmoidf_(a4[2]); v[3] += bfhi(w2.y) * sigmoidf_(a4[3]);
                    }
                u32x2 w; w.x = cvt_pk_bf16(v[0], v[1]); w.y = cvt_pk_bf16(v[2], v[3]);
                *(u32x2*)(MB + (size_t)row * D + c) = w;
            }
        }
    }
};

DEV const float* wsrc(const float* src, const float* src2, int map, int n) {
    switch (map) {
        case 1: { const int t = n >> 8, r = n & 255; return (r < 128) ? src + t * 128 + r : src2 + t * 128 + r - 128; }
        case 2: { if (n < 3232) return src + n; return nullptr; }
        case 3: { const int pn = n >> 8, loc = n & 255, bj = loc >> 7, wc = (loc >> 5) & 3, n16 = (loc >> 4) & 1, i = loc & 15; return src + 3232 + (2 * bj + n16) * 1024 + pn * 64 + wc * 16 + i; }
        case 5: { const int br = n >> 10, dd = n & 1023; return src + (size_t)br * 512 * 1024 + dd; }
        default: return src + n;
    }
}
DEV void wprep_item(const float* src, const float* src2, bf16_t* dst, int srcN, int K, int map, int item, float* scr  , int lane) {
    const int nkb = K / 64, nb = item / nkb, kb = item % nkb, k0 = kb * 64, n0 = nb * 64;
    const float* cp = wsrc(src, src2, map, n0 + (lane & 15) * 4);
    f32x4 v[16];
#pragma unroll
    for (int i = 0; i < 16; ++i) { const int kk = 4 * i + (lane >> 4); v[i] = cp ? *(const f32x4*)(cp + (size_t)(k0 + kk) * srcN) : (f32x4){0.f, 0.f, 0.f, 0.f}; }
#pragma unroll
    for (int i = 0; i < 16; ++i) { float* w = scr + (4 * i + (lane >> 4)) * 65 + (lane & 15) * 4; w[0] = v[i][0]; w[1] = v[i][1]; w[2] = v[i][2]; w[3] = v[i][3]; }
    asm volatile("s_waitcnt lgkmcnt(0)" ::: "memory");
    const int c = lane & 7;
#pragma unroll
    for (int j = 0; j < 8; ++j) { const int n = (lane >> 3) + 8 * j; const float* s = scr + (8 * c) * 65 + n;
        u32x4 o; o.x = cvt_pk_bf16(s[0 * 65], s[1 * 65]); o.y = cvt_pk_bf16(s[2 * 65], s[3 * 65]); o.z = cvt_pk_bf16(s[4 * 65], s[5 * 65]); o.w = cvt_pk_bf16(s[6 * 65], s[7 * 65]);
        *(u32x4*)(dst + (size_t)(n0 + n) * K + k0 + 8 * c) = o; }
    asm volatile("s_waitcnt lgkmcnt(0)" ::: "memory");
}
DEV void wprep_phase(const int TID, KPP p, unsigned char* lds, int layer, int which) {
    const int lane = TID & 63, wid = __builtin_amdgcn_readfirstlane(TID >> 6);
    __syncthreads();
    float* scr = (float*)(lds + wid * 16640);
    const int gw = wid * gridDim.x + blockIdx.x, NGW = gridDim.x * NWAVES;
    unsigned char* wbp = p->ws + WS_WB;
    const int total = which ? 2112 : 4880;
    for (int it0 = gw; it0 < total; it0 += NGW) {
        int it = __builtin_amdgcn_readfirstlane(it0);
        const float* src; const float* src2; bf16_t* dst; int srcN, K, map;
#define WJ(cnt, S, S2, OFF, SRCN, KK, MAP) if (it < (cnt)) { src = (S); src2 = (S2); dst = (bf16_t*)(wbp + (OFF)); srcN = (SRCN); K = (KK); map = (MAP); } else { it -= (cnt);
        if (which == 0) {
            WJ(1408, p->in[7] + (size_t)layer * D * DFF, p->in[8] + (size_t)layer * D * DFF, WB_GU, DFF, D, 1)
            WJ(704, p->in[9] + (size_t)layer * DFF * D, src, WB_DN, D, DFF, 0)
            WJ(832, p->in[11] + (size_t)layer * D * INCOLS, src, WB_INA, INCOLS, D, 2)
            WJ(1024, p->in[11] + (size_t)layer * D * INCOLS, src, WB_G, INCOLS, D, 3)
            WJ(48, p->in[25] + (size_t)layer * 256 * 768, src, WB_UQ, 768, 256, 0)
            WJ(32, p->in[27] + (size_t)layer * 128 * 1024, src, WB_UKV, 1024, 128, 0)
            WJ(512, p->in[28] + (size_t)layer * 4 * 512 * 1024, src, WB_BR, 1024, 512, 5)
            WJ(256, p->in[29] + (size_t)layer * D * D, src, WB_OUT, D, D, 0)
            { src = p->in[22] + (size_t)layer * 512 * 512; src2 = src; dst = (bf16_t*)(wbp + WB_GLU); srcN = 512; K = 512; map = 0; }
            }}}}}}}}
        } else {
            WJ(1408, p->in[31] + (size_t)layer * D * DFF, p->in[32] + (size_t)layer * D * DFF, WB_GU, DFF, D, 1)
            { src = p->in[33] + (size_t)layer * DFF * D; src2 = src; dst = (bf16_t*)(wbp + WB_DN); srcN = D; K = DFF; map = 0; }
            }
        }
#undef WJ
        wprep_item(src, src2, dst, srcN, K, map, it, scr, lane);
    }
    __syncthreads();
}

DEV void modp_phase(const int TID, KPP p, unsigned char* lds) {
    float* S = (float*)lds;
    const int tid = TID, lane = tid & 63, wid = tid >> 6;
    __syncthreads();
    for (int i = tid; i < 5 * 1024; i += NTHREADS) { const float x = (i < 4096) ? p->in[1][i] : p->in[3][i - 4096]; S[i] = x * sigmoidf_(x); }
    __syncthreads();
    float* MOD = (float*)(p->ws + WS_MOD);
    const int gw = wid * gridDim.x + blockIdx.x, NGW = gridDim.x * NWAVES;
    for (int it = gw; it < 2 * 144 * KSPLIT; it += NGW) {
        const int ks = it % KSPLIT, jb = (it / KSPLIT) % 144, l = it / (KSPLIT * 144);
        const float* W = p->in[4] + (size_t)l * D * 9216 + jb * 64 + lane;
        float a0 = 0.f, a1 = 0.f, a2 = 0.f, a3 = 0.f, a4 = 0.f;
#pragma unroll 8
        for (int kk = 0; kk < 64; ++kk) { const int k = ks * 64 + kk; const float w = W[(size_t)k * 9216];
            a0 += S[k] * w; a1 += S[1024 + k] * w; a2 += S[2048 + k] * w; a3 += S[3072 + k] * w; a4 += S[4096 + k] * w; }
        float* o = MOD + (size_t)l * 5 * 9216 + jb * 64 + lane;
        const float bs = (ks == 0) ? p->in[5][l * 9216 + jb * 64 + lane] : 0.f;
        atomicAdd(o, a0 + bs); atomicAdd(o + 9216, a1 + bs); atomicAdd(o + 2 * 9216, a2 + bs); atomicAdd(o + 3 * 9216, a3 + bs); atomicAdd(o + 4 * 9216, a4 + bs);
    }
    __syncthreads();
}
DEV void norm_phase(const int TID, KPP p, const float* hlat, const float* hctx, const float* w, const float* modl  , int ishift, int nrows) {
    bf16_t* XN = (bf16_t*)(p->ws + WS_XN);
    const int lane = TID & 63, wid = TID >> 6;
    const int gw = wid * gridDim.x + blockIdx.x, NGW = gridDim.x * NWAVES;
    f32x4 w4[4];
#pragma unroll
    for (int j = 0; j < 4; ++j) w4[j] = *(const f32x4*)(w + j * 256 + lane * 4);
    for (int r = gw; r < nrows; r += NGW) {
        const float* xr = (r < M_LAT) ? hlat + (size_t)r * D : hctx + (size_t)(r - M_LAT) * D;
        const int v = (r < M_LAT) ? (r >> 12) : 4;
        const float* sh = modl + ((size_t)v * 9 + ishift) * 1024; const float* sc = sh + 1024;
        f32x4 x[4], s4[4], c4[4]; float ss = 0.f;
#pragma unroll
        for (int j = 0; j < 4; ++j) { x[j] = *(const f32x4*)(xr + j * 256 + lane * 4); s4[j] = *(const f32x4*)(sh + j * 256 + lane * 4); c4[j] = *(const f32x4*)(sc + j * 256 + lane * 4); }
#pragma unroll
        for (int j = 0; j < 4; ++j) ss += x[j][0] * x[j][0] + x[j][1] * x[j][1] + x[j][2] * x[j][2] + x[j][3] * x[j][3];
        const float rs = rsqrtf(wave_sum(ss, lane) * (1.f / D) + EPS);
#pragma unroll
        for (int j = 0; j < 4; ++j) {
            const int c = j * 256 + lane * 4;
            const f32x4 y = x[j] * rs * w4[j] * (c4[j] + 1.f) + s4[j];
            u32x2 o; o.x = cvt_pk_bf16(y[0], y[1]); o.y = cvt_pk_bf16(y[2], y[3]);
            *(u32x2*)(XN + (size_t)r * D + c) = o;
        }
    }
}
DEV void rope_inplace(bf16_t* x1p, bf16_t* x2p, float pos, float invf) {
    const float ang = pos * invf, cs = __cosf(ang), sn = __sinf(ang);
    const float a = bf2f(*x1p), b = bf2f(*x2p);
    *x1p = f2bf(a * cs - b * sn); *x2p = f2bf(b * cs + a * sn);
}
DEV void mlanorm_phase(const int TID, KPP p, const float* qw, const float* kvw) {
    bf16_t* WA = (bf16_t*)(p->ws + WS_BIG + BIG_WA);
    const int lane = TID & 63, wid = TID >> 6;
    const int gw = wid * gridDim.x + blockIdx.x, NGW = gridDim.x * NWAVES;
    const bool ract = lane < 42;
    int rbase, rxoff, ri0, rpt; float rfd;
    if (lane < 32) { const int hd = lane >> 2, hf = lane & 1; rpt = (lane >> 1) & 1; rbase = C_SWQ + hd * 64 + rpt * 32 + hf * 8; rxoff = 16; ri0 = hf * 8; rfd = 13.287712379549449f / 16.f; }
    else if (lane < 40) { const int l2 = lane - 32, hd = l2 >> 2, hf = l2 & 1; rpt = (l2 >> 1) & 1; rbase = C_SWK + hd * 64 + rpt * 32 + hf * 8; rxoff = 16; ri0 = hf * 8; rfd = 13.287712379549449f / 16.f; }
    else { rpt = (lane - 40) & 1; rbase = C_KR + rpt * 16; rxoff = 8; ri0 = 0; rfd = 13.287712379549449f / 8.f; }
    float rinvf[8];
#pragma unroll
    for (int j = 0; j < 8; ++j) rinvf[j] = __builtin_amdgcn_exp2f(-(float)(ri0 + j) * rfd);
    for (int r = gw; r < M_ALL; r += NGW) {
        bf16_t* q = WA + (size_t)r * WA_N + C_CQ + lane * 4;
        const u32x2 qv = *(const u32x2*)q;
        const float q0 = bflo(qv.x), q1 = bfhi(qv.x), q2 = bflo(qv.y), q3 = bfhi(qv.y);
        const float rq = rsqrtf(wave_sum(q0 * q0 + q1 * q1 + q2 * q2 + q3 * q3, lane) * (1.f / 256.f) + EPS);
        const f32x4 w4 = *(const f32x4*)(qw + lane * 4);
        u32x2 o; o.x = cvt_pk_bf16(q0 * rq * w4[0], q1 * rq * w4[1]); o.y = cvt_pk_bf16(q2 * rq * w4[2], q3 * rq * w4[3]);
        *(u32x2*)q = o;
        bf16_t* k = WA + (size_t)r * WA_N + C_CKV + lane * 2;
        const unsigned kv = *(const unsigned*)k;
        const float k0 = bflo(kv), k1 = bfhi(kv);
        const float rk = rsqrtf(wave_sum(k0 * k0 + k1 * k1, lane) * (1.f / 128.f) + EPS);
        *(unsigned*)k = cvt_pk_bf16(k0 * rk * kvw[lane * 2], k1 * rk * kvw[lane * 2 + 1]);
        if (r < M_LAT && ract) {
            const int t = r & 4095; const float pos = (float)(rpt ? (t & 63) : (t >> 6));
            bf16_t* x1p = WA + (size_t)r * WA_N + rbase;
            const u32x4 a = *(const u32x4*)x1p, b2 = *(const u32x4*)(x1p + rxoff);
            const float av[8] = {bflo(a.x), bfhi(a.x), bflo(a.y), bfhi(a.y), bflo(a.z), bfhi(a.z), bflo(a.w), bfhi(a.w)};
            const float bv[8] = {bflo(b2.x), bfhi(b2.x), bflo(b2.y), bfhi(b2.y), bflo(b2.z), bfhi(b2.z), bflo(b2.w), bfhi(b2.w)};
            float o1[8], o2[8];
#pragma unroll
            for (int j = 0; j < 8; ++j) { const float ang = pos * rinvf[j], cs = __cosf(ang), sn = __sinf(ang); o1[j] = av[j] * cs - bv[j] * sn; o2[j] = bv[j] * cs + av[j] * sn; }
            u32x4 w1, w2; w1.x = cvt_pk_bf16(o1[0], o1[1]); w1.y = cvt_pk_bf16(o1[2], o1[3]); w1.z = cvt_pk_bf16(o1[4], o1[5]); w1.w = cvt_pk_bf16(o1[6], o1[7]);
            w2.x = cvt_pk_bf16(o2[0], o2[1]); w2.y = cvt_pk_bf16(o2[2], o2[3]); w2.z = cvt_pk_bf16(o2[4], o2[5]); w2.w = cvt_pk_bf16(o2[6], o2[7]);
            *(u32x4*)x1p = w1; *(u32x4*)(x1p + rxoff) = w2;
        }
    }
}
DEV void final_phase(const int TID, KPP p) {
    const float* w = p->in[34];
    const int lane = TID & 63, wid = TID >> 6;
    const int gw = wid * gridDim.x + blockIdx.x, NGW = gridDim.x * NWAVES;
    for (int r = gw; r < M_LAT; r += NGW) {
        float* xr = p->out + (size_t)r * D;
        f32x4 x[4]; float ss = 0.f;
#pragma unroll
        for (int j = 0; j < 4; ++j) { x[j] = *(const f32x4*)(xr + j * 256 + lane * 4); ss += x[j][0] * x[j][0] + x[j][1] * x[j][1] + x[j][2] * x[j][2] + x[j][3] * x[j][3]; }
        const float rs = rsqrtf(wave_sum(ss, lane) * (1.f / D) + EPS);
#pragma unroll
        for (int j = 0; j < 4; ++j) { const int c = j * 256 + lane * 4; *(f32x4*)(xr + c) = x[j] * rs * *(const f32x4*)(w + c); }
    }
}

struct S5L { const float *lre, *lim, *ldt, *bre, *bim, *cre, *cim, *dsk; };
DEV void s5_lambar(const S5L& L, int gi, int pp, float& lre, float& lim, float& dt, float& lbr, float& lbi) {
    lre = L.lre[gi * 64 + pp]; lim = L.lim[gi * 64 + pp]; dt = __expf(L.ldt[gi]);
    const float er = __expf(lre * dt), ang = lim * dt;
    lbr = er * cosf(ang); lbi = er * sinf(ang);
}
DEV void s5_coef(float lre, float lim, float lbr, float lbi, float& cr, float& ci) {
    const float ar = lbr - 1.f, ai = lbi, den = 1.f / (lre * lre + lim * lim);
    cr = (ar * lre + ai * lim) * den; ci = (ai * lre - ar * lim) * den;
}
DEV int s5_row(int b, int dir, int k, int s) {
    const int pos = k * 64 + s;
    if (dir == 0) return pos < 256 ? M_LAT + b * 256 + pos : b * 4096 + (pos - 256);
    return pos < 256 ? M_LAT + b * 256 + (255 - pos) : b * 4096 + (4095 - (pos - 256));
}
DEV void s5_pre_phase(const int TID, KPP p, const S5L& L, unsigned char* lds, const int b0, const int nbk) {
    if ((int)blockIdx.x < b0) return;
    const int bj = (int)blockIdx.x - b0;
    bf16_t* KERN = (bf16_t*)(p->ws + WS_KERN); bf16_t* W3 = (bf16_t*)(p->ws + WS_WB);
    float2* Cs = (float2*)lds; float2* Bs = Cs + 1024; float2* PWs = Bs + 1024;
    for (int it = bj; it < 256; it += nbk) {
        const int dg = it >> 2, dq = it & 3;
        __syncthreads();
        for (int idx = TID; idx < 1024; idx += NTHREADS) {
            { const int c = idx >> 6, pp = idx & 63; Cs[idx] = make_float2(L.cre[(dg * 16 + c) * 64 + pp], L.cim[(dg * 16 + c) * 64 + pp]); }
            { const int pp = idx >> 4, c2 = idx & 15; float lre, lim, dt, lbr, lbi, cr, ci; s5_lambar(L, dg, pp, lre, lim, dt, lbr, lbi); s5_coef(lre, lim, lbr, lbi, cr, ci);
              const float br = L.bre[(size_t)(dg * 64 + pp) * 16 + c2], bi = L.bim[(size_t)(dg * 64 + pp) * 16 + c2];
              Bs[idx] = make_float2(cr * br - ci * bi, cr * bi + ci * br); }
            { const int dd = idx >> 6, pp = idx & 63; const float d = (float)(dq * 16 + dd);
              const float lre = L.lre[dg * 64 + pp], lim = L.lim[dg * 64 + pp], dt = __expf(L.ldt[dg]);
              const float er = __expf(d * lre * dt), ang = d * lim * dt; PWs[idx] = make_float2(er * cosf(ang), er * sinf(ang)); }
        }
        __syncthreads();
        {
            const int c2h = TID & 1, c = (TID >> 1) & 15, dd = TID >> 5;
            float sum[8];
#pragma unroll
            for (int j = 0; j < 8; ++j) sum[j] = 0.f;
#pragma unroll 4
            for (int pp = 0; pp < 64; ++pp) { const float2 cc = Cs[c * 64 + pp], pw = PWs[dd * 64 + pp];
                const float gr = cc.x * pw.x - cc.y * pw.y, gi = cc.x * pw.y + cc.y * pw.x;
                const f32x4* bp = (const f32x4*)(Bs + pp * 16 + c2h * 8);
#pragma unroll
                for (int q = 0; q < 4; ++q) { const f32x4 b2 = bp[q]; sum[2 * q] += gr * b2[0] - gi * b2[1]; sum[2 * q + 1] += gr * b2[2] - gi * b2[3]; } }
            u32x4 w; w.x = cvt_pk_bf16(sum[0], sum[1]); w.y = cvt_pk_bf16(sum[2], sum[3]); w.z = cvt_pk_bf16(sum[4], sum[5]); w.w = cvt_pk_bf16(sum[6], sum[7]);
            *(u32x4*)(KERN + (size_t)((dg * 64 + dq * 16 + dd) * 16 + c) * 16 + c2h * 8) = w;
        }
    }
    __syncthreads();
    for (int un = (TID >> 6) * nbk + bj; un < 64 * 16; un += nbk * NWAVES) {
        const int pp = TID & 63, c = un & 15, dg = un >> 4;
        float lre, lim, dt, lbr, lbi; s5_lambar(L, dg, pp, lre, lim, dt, lbr, lbi);
        const float cr = L.cre[(dg * 16 + c) * 64 + pp], ci = L.cim[(dg * 16 + c) * 64 + pp];
        float pr = lbr, pi = lbi;
        bf16_t* o = W3 + (size_t)(dg * 64 * 16 + c) * 128 + pp;
#pragma unroll 4
        for (int e = 0; e < 64; ++e) {
            o[(size_t)e * 16 * 128] = f2bf(cr * pr - ci * pi); o[(size_t)e * 16 * 128 + 64] = f2bf(-(cr * pi + ci * pr));
            const float nr = pr * lbr - pi * lbi, ni = pr * lbi + pi * lbr; pr = nr; pi = ni;
        }
    }
}
DEV void s5_local_phase(const int TID, KPP p, const S5L& L) {
    const bf16_t* WA = (const bf16_t*)(p->ws + WS_BIG + BIG_WA); float2* SB = (float2*)(p->ws + WS_S5);
    const int lane = TID & 63, wid = __builtin_amdgcn_readfirstlane(TID >> 6), fr = lane & 15, fq = lane >> 4, sh = fq >> 1, c0 = (fq & 1) * 8;
    const int gw = wid * gridDim.x + blockIdx.x, NGW = gridDim.x * NWAVES;
    for (int it = gw; it < 768; it += NGW) {
        const int nh = it % 3, mbp = (it / 3) & 3, dg = it / 12, dir = dg >> 5, g = dg & 31, pp = mbp * 16 + fr;
        float lre, lim, dt, lbr, lbi, cr, ci; s5_lambar(L, dg, pp, lre, lim, dt, lbr, lbi); s5_coef(lre, lim, lbr, lbi, cr, ci);
        float bbr[8], bbi[8];
        { const f32x4* brp = (const f32x4*)(L.bre + (size_t)(dg * 64 + pp) * 16 + c0); const f32x4* bip = (const f32x4*)(L.bim + (size_t)(dg * 64 + pp) * 16 + c0);
#pragma unroll
          for (int q = 0; q < 2; ++q) { const f32x4 r4 = brp[q], i4 = bip[q];
#pragma unroll
              for (int j = 0; j < 4; ++j) { bbr[q * 4 + j] = cr * r4[j] - ci * i4[j]; bbi[q * 4 + j] = cr * i4[j] + ci * r4[j]; } } }
        const float l2r = lbr * lbr - lbi * lbi, l2i = 2.f * lbr * lbi;
        float pr = sh ? 1.f : lbr, pi = sh ? 0.f : lbi;
        const int NB = (nh < 2) ? 6 : 5, nb0 = nh * 6;
        const bf16_t* ub[6]; int kcol[6];
#pragma unroll
        for (int nb = 0; nb < 6; ++nb) { int col = (nb0 + nb) * 16 + fr; if (col > 271) col = 271; const int b = col / 68, k = col % 68;
            kcol[nb] = (b * 2 + dir) * 68 + k; ub[nb] = WA + (size_t)s5_row(b, dir, k, 0) * WA_N + C_S5U + g * 16 + c0; }
        const ptrdiff_t sstep = (dir == 0) ? (ptrdiff_t)WA_N : -(ptrdiff_t)WA_N;
        f32x4 are[6], aim[6];
#pragma unroll
        for (int nb = 0; nb < 6; ++nb) { are[nb] = (f32x4){0.f, 0.f, 0.f, 0.f}; aim[nb] = (f32x4){0.f, 0.f, 0.f, 0.f}; }
        bf16x8 Bc[6], Bn[6], Bm[6];
#pragma unroll
        for (int nb = 0; nb < 6; ++nb) { Bc[nb] = *(const bf16x8*)(ub[nb] + (ptrdiff_t)(62 + sh) * sstep); Bn[nb] = *(const bf16x8*)(ub[nb] + (ptrdiff_t)(60 + sh) * sstep); Bm[nb] = Bn[nb]; }
#pragma unroll 1
        for (int kc = 31; kc >= 0; --kc) {
            if (kc > 1) {
#pragma unroll
                for (int nb = 0; nb < 6; ++nb) if (nb < NB) Bm[nb] = *(const bf16x8*)(ub[nb] + (ptrdiff_t)(2 * kc - 4 + sh) * sstep);
            }
            u32x4 wr_, wi_;
            wr_.x = cvt_pk_bf16(pr * bbr[0] - pi * bbi[0], pr * bbr[1] - pi * bbi[1]); wr_.y = cvt_pk_bf16(pr * bbr[2] - pi * bbi[2], pr * bbr[3] - pi * bbi[3]);
            wr_.z = cvt_pk_bf16(pr * bbr[4] - pi * bbi[4], pr * bbr[5] - pi * bbi[5]); wr_.w = cvt_pk_bf16(pr * bbr[6] - pi * bbi[6], pr * bbr[7] - pi * bbi[7]);
            wi_.x = cvt_pk_bf16(pr * bbi[0] + pi * bbr[0], pr * bbi[1] + pi * bbr[1]); wi_.y = cvt_pk_bf16(pr * bbi[2] + pi * bbr[2], pr * bbi[3] + pi * bbr[3]);
            wi_.z = cvt_pk_bf16(pr * bbi[4] + pi * bbr[4], pr * bbi[5] + pi * bbr[5]); wi_.w = cvt_pk_bf16(pr * bbi[6] + pi * bbr[6], pr * bbi[7] + pi * bbr[7]);
            const bf16x8 Ar = __builtin_bit_cast(bf16x8, wr_), Ai = __builtin_bit_cast(bf16x8, wi_);
#pragma unroll
            for (int nb = 0; nb < 6; ++nb) if (nb < NB) {
                are[nb] = __builtin_amdgcn_mfma_f32_16x16x32_bf16(Ar, Bc[nb], are[nb], 0, 0, 0);
                aim[nb] = __builtin_amdgcn_mfma_f32_16x16x32_bf16(Ai, Bc[nb], aim[nb], 0, 0, 0);
            }
#pragma unroll
            for (int nb = 0; nb < 6; ++nb) { Bc[nb] = Bn[nb]; Bn[nb] = Bm[nb]; }
            const float nr = pr * l2r - pi * l2i, ni = pr * l2i + pi * l2r; pr = nr; pi = ni;
        }
#pragma unroll
        for (int nb = 0; nb < 6; ++nb) if (nb < NB) {
            float2* o = SB + (size_t)kcol[nb] * 2048 + g * 64 + mbp * 16 + fq * 4;
#pragma unroll
            for (int j = 0; j < 4; ++j) o[j] = make_float2(are[nb][j], aim[nb][j]);
        }
    }
}
DEV void s5_carry_phase(const int TID, KPP p, const S5L& L) {
    const float2* __restrict__ SB = (const float2*)(p->ws + WS_S5); bf16_t* __restrict__ SBH = (bf16_t*)(p->ws + WS_SBH);
    if (TID >= 64) return;
    for (int idx = blockIdx.x * 64 + TID; idx < 4 * 2 * 32 * 64; idx += gridDim.x * 64) {
        const int pp = idx & 63, g = (idx >> 6) & 31, dir = (idx >> 11) & 1, b = idx >> 12;
        float lre, lim, dt, ar, ai; s5_lambar(L, dir * 32 + g, pp, lre, lim, dt, ar, ai);
#pragma unroll
        for (int q = 0; q < 6; ++q) { const float nr = ar * ar - ai * ai, ni = 2.f * ar * ai; ar = nr; ai = ni; }
        float sr = 0.f, si = 0.f;
        const float2* base = SB + (size_t)((b * 2 + dir) * 68) * 2048 + g * 64 + pp;
        bf16_t* ob = SBH + (size_t)((b * 2 + dir) * 68) * 4096 + g * 128 + pp;
#pragma unroll 17
        for (int k = 0; k < 68; ++k) { const float2 e = base[(size_t)k * 2048];
            ob[(size_t)k * 4096] = f2bf(sr); ob[(size_t)k * 4096 + 64] = f2bf(si);
            const float nr = ar * sr - ai * si + e.x, ni = ar * si + ai * sr + e.y; sr = nr; si = ni; }
    }
}
DEV float gelu_tanh(float x) { const float z = 0.7978845608028654f * (x + 0.044715f * x * x * x); const float t = 1.f - 2.f * __builtin_amdgcn_rcpf(1.f + __expf(2.f * z)); return 0.5f * x * (1.f + t); }
DEV void s5_out_phase(const int TID, KPP p, const S5L& L, bool lastl) {
    const bf16_t* WA = (const bf16_t*)(p->ws + WS_BIG + BIG_WA); const bf16_t* SBH = (const bf16_t*)(p->ws + WS_SBH); bf16_t* G5 = (bf16_t*)(p->ws + WS_G5);
    const bf16_t* KERN = (const bf16_t*)(p->ws + WS_KERN); const bf16_t* W3 = (const bf16_t*)(p->ws + WS_WB);
    const int lane = TID & 63, wid = __builtin_amdgcn_readfirstlane(TID >> 6), fr = lane & 15, fq = lane >> 4, sh = fq >> 1, c0 = (fq & 1) * 8;
    const int gw = wid * gridDim.x + blockIdx.x, NGW = gridDim.x * NWAVES;
    const int NG = lastl ? 4 : 5, ncols = lastl ? 256 : 272;
    for (int it = gw; it < 32 * 16 * NG; it += NGW) {
        const int ng = it % NG, tg = (it / NG) & 15, g = it / (NG * 16), t0 = tg * 4;
        int rowb[4]; const bf16_t* sbf[4]; const bf16_t* sbr[4];
#pragma unroll
        for (int nb = 0; nb < 4; ++nb) { int col = (ng * 4 + nb) * 16 + fr; if (col >= ncols) col = ncols - 1;
            const int b = lastl ? (col >> 6) : (col / 68), tc = lastl ? 4 + (col & 63) : (col % 68);
            rowb[nb] = (tc < 4) ? M_LAT + b * 256 + tc * 64 : b * 4096 + (tc - 4) * 64;
            const int kr = (tc < 4) ? 3 - tc : 71 - tc;
            sbf[nb] = SBH + (size_t)(((b * 2 + 0) * 68 + tc) * 32 + g) * 128 + fq * 8; sbr[nb] = SBH + (size_t)(((b * 2 + 1) * 68 + kr) * 32 + g) * 128 + fq * 8; }
        const int nvalid = (ncols - ng * 64 + 15) >> 4;
        f32x4 acc[4][4];
#pragma unroll
        for (int ti = 0; ti < 4; ++ti)
#pragma unroll
            for (int nb = 0; nb < 4; ++nb) acc[ti][nb] = (f32x4){0.f, 0.f, 0.f, 0.f};
        const bf16_t* kf = KERN + (size_t)(g * 64 * 16 + fr) * 16 + c0; const bf16_t* kr_ = KERN + (size_t)((32 + g) * 64 * 16 + fr) * 16 + c0;
#define S5O_LOAD(Bs_, Af_, Ar_, kc_) do { const int _tq = 2 * (kc_) + sh; \
            _Pragma("unroll") for (int nb = 0; nb < 4; ++nb) Bs_[nb] = *(const bf16x8*)(WA + (size_t)(rowb[nb] + _tq) * WA_N + C_S5U + g * 16 + c0); \
            _Pragma("unroll") for (int ti = 0; ti < 4; ++ti) { const int _df = t0 + ti - _tq, _dr = _tq - t0 - ti; \
                u32x4 _a = *(const u32x4*)(kf + (size_t)(_df < 0 ? 0 : _df) * 256); if (_df < 0) _a = (u32x4){0u, 0u, 0u, 0u}; Af_[ti] = __builtin_bit_cast(bf16x8, _a); \
                u32x4 _b = *(const u32x4*)(kr_ + (size_t)(_dr < 0 ? 0 : _dr) * 256); if (_dr < 0) _b = (u32x4){0u, 0u, 0u, 0u}; Ar_[ti] = __builtin_bit_cast(bf16x8, _b); } } while (0)
#define S5O_MMA(Bs_, Af_, Ar_, kc_) do { \
            _Pragma("unroll") for (int ti = 0; ti < 4; ++ti) { const int t = t0 + ti; \
                if (t >= 2 * (kc_)) { _Pragma("unroll") for (int nb = 0; nb < 4; ++nb) if (nb < nvalid) acc[ti][nb] = __builtin_amdgcn_mfma_f32_16x16x32_bf16(Af_[ti], Bs_[nb], acc[ti][nb], 0, 0, 0); } \
                if (2 * (kc_) + 1 >= t) { _Pragma("unroll") for (int nb = 0; nb < 4; ++nb) if (nb < nvalid) acc[ti][nb] = __builtin_amdgcn_mfma_f32_16x16x32_bf16(Ar_[ti], Bs_[nb], acc[ti][nb], 0, 0, 0); } } } while (0)
        {
            bf16x8 B0[4], F0[4], R0[4], B1[4], F1[4], R1[4];
            S5O_LOAD(B0, F0, R0, 0);
#pragma unroll 1
            for (int kc = 0; kc < 32; kc += 2) {
                S5O_LOAD(B1, F1, R1, kc + 1);
                S5O_MMA(B0, F0, R0, kc);
                if (kc + 2 < 32) S5O_LOAD(B0, F0, R0, kc + 2);
                S5O_MMA(B1, F1, R1, kc + 1);
            }
        }
#undef S5O_LOAD
#undef S5O_MMA
#pragma unroll 1
        for (int dir = 0; dir < 2; ++dir)
#pragma unroll
            for (int kc2 = 0; kc2 < 4; ++kc2) {
                bf16x8 B[4];
#pragma unroll
                for (int nb = 0; nb < 4; ++nb) B[nb] = *(const bf16x8*)((dir ? sbr[nb] : sbf[nb]) + kc2 * 32);
#pragma unroll
                for (int ti = 0; ti < 4; ++ti) { const int t = t0 + ti, e = dir ? 63 - t : t;
                    const bf16x8 A = *(const bf16x8*)(W3 + (size_t)(((dir * 32 + g) * 64 + e) * 16 + fr) * 128 + kc2 * 32 + fq * 8);
#pragma unroll
                    for (int nb = 0; nb < 4; ++nb) if (nb < nvalid) acc[ti][nb] = __builtin_amdgcn_mfma_f32_16x16x32_bf16(A, B[nb], acc[ti][nb], 0, 0, 0); }
            }
        const f32x4 dsk = *(const f32x4*)(L.dsk + g * 16 + fq * 4);
#pragma unroll
        for (int nb = 0; nb < 4; ++nb) if (nb < nvalid)
#pragma unroll
            for (int ti = 0; ti < 4; ++ti) {
                const size_t row = (size_t)(rowb[nb] + t0 + ti);
                const u32x2 uw = *(const u32x2*)(WA + row * WA_N + C_S5U + g * 16 + fq * 4);
                const f32x4 a = acc[ti][nb];
                const float y0 = gelu_tanh(a[0] + dsk[0] * bflo(uw.x)), y1 = gelu_tanh(a[1] + dsk[1] * bfhi(uw.x)), y2 = gelu_tanh(a[2] + dsk[2] * bflo(uw.y)), y3 = gelu_tanh(a[3] + dsk[3] * bfhi(uw.y));
                u32x2 w; w.x = cvt_pk_bf16(y0, y1); w.y = cvt_pk_bf16(y2, y3);
                *(u32x2*)(G5 + row * 512 + g * 16 + fq * 4) = w;
            }
    }
}

struct AttnP { const bf16_t* WA; const bf16_t* MLAQ; const bf16_t* MLAKV; bf16_t* Y; const float* rpb; const float* sink; };
typedef float f32x16 __attribute__((ext_vector_type(16)));
DEV float half_max(float x) { auto q = __builtin_amdgcn_permlane32_swap(__float_as_uint(x), __float_as_uint(x), false, false); return fmaxf(__uint_as_float(q[0]), __uint_as_float(q[1])); }
DEV float half_sum(float x) { auto q = __builtin_amdgcn_permlane32_swap(__float_as_uint(x), __float_as_uint(x), false, false); return __uint_as_float(q[0]) + __uint_as_float(q[1]); }
template <int TYPE  >
DEV void attn_item(const int TID, unsigned char* lds, const AttnP& P, int b, int h, int qt) {
    constexpr int DQ = (TYPE == 2) ? 96 : 64, NC = DQ / 16, KPI = DQ + 8, VPI = 68, BUFSZ = 22016;
    float* rp = (float*)(lds + 2 * BUFSZ);
    const int tid = TID, lane = tid & 63, wid = __builtin_amdgcn_readfirstlane(tid >> 6), l31 = lane & 31, hi = lane >> 5;
    const bool cq = (qt == 16);
    const int qrow0 = cq ? M_LAT + b * 256 : b * 4096 + qt * 256;
    const bf16_t *Qp, *K0p, *Vp; int qpitch, kpitch;
    if (TYPE == 0) { Qp = P.WA + C_NAQ + h * 64; qpitch = WA_N; K0p = P.WA + C_NAK + h * 64; Vp = P.WA + C_NAV + h * 64; kpitch = WA_N; }
    else if (TYPE == 1) { Qp = P.WA + C_SWQ + h * 64; qpitch = WA_N; K0p = P.WA + C_SWK + (h >> 2) * 64; Vp = P.WA + C_SWV + (h >> 2) * 64; kpitch = WA_N; }
    else { Qp = P.MLAQ + h * 96; qpitch = 768; K0p = P.MLAKV + h * 128; Vp = P.MLAKV + h * 128 + 64; kpitch = 1024; }
    const bf16_t* K1p = P.WA + C_KR;
    int lo = 0, hi_t = 0, wlo = 0, whi = 0;
    const int qw = qt * 256 + wid * 32;
    if (!cq) {
        if (TYPE == 0) { lo = clampi(qt * 4 - 4, 0, 56); hi_t = clampi(qt * 4 + 3 - 4, 0, 56) + 8; wlo = clampi((qw >> 6) - 4, 0, 56); whi = wlo + 8; }
        else if (TYPE == 1) { lo = qt * 4 - 2; if (lo < 0) lo = 0; hi_t = qt * 4 + 6; if (hi_t > 64) hi_t = 64;
            wlo = (qw - 128 < 0 ? 0 : qw - 128) >> 6; whi = ((qw + 31 + 128) >> 6) + 1; if (whi > 64) whi = 64; }
        else { lo = 0; hi_t = 64; wlo = 0; whi = 64; }
    }
    const int nloc = hi_t - lo, nt = nloc + 4;
    const float sc = ((TYPE == 2) ? 0.10206207261596575f : 0.125f) * LOG2E;
    __syncthreads();
    if (TYPE == 0 && !cq && tid < 465) rp[tid] = P.rpb[h * 465 + tid] * LOG2E;
    const int qrow = qrow0 + wid * 32 + l31;
    bf16x8 Qf[NC];
#pragma unroll
    for (int c = 0; c < NC; ++c) {
        const u32x4 w = *(const u32x4*)(Qp + (size_t)qrow * qpitch + c * 16 + hi * 8);
        float v[8] = {bflo(w.x), bfhi(w.x), bflo(w.y), bfhi(w.y), bflo(w.z), bfhi(w.z), bflo(w.w), bfhi(w.w)};
        if (TYPE == 2 && c >= 4 && !cq) {
            const int t = qrow & 4095; const float pos = (float)((c == 5) ? (t & 63) : (t >> 6));
#pragma unroll
            for (int j = 0; j < 8; ++j) {
                const float other = shflx(v[j], lane, 32);
                const float ang = pos * __builtin_amdgcn_exp2f(-(float)j * (13.287712379549449f / 8.f)), cs = __cosf(ang), sn = __sinf(ang);
                v[j] = hi ? (v[j] * cs + other * sn) : (v[j] * cs - other * sn);
            }
        }
        u32x4 o; o.x = cvt_pk_bf16(v[0] * sc, v[1] * sc); o.y = cvt_pk_bf16(v[2] * sc, v[3] * sc); o.z = cvt_pk_bf16(v[4] * sc, v[5] * sc); o.w = cvt_pk_bf16(v[6] * sc, v[7] * sc);
        Qf[c] = __builtin_bit_cast(bf16x8, o);
    }
    f32x16 O[2]; float mrun, lrun;
#pragma unroll
    for (int db = 0; db < 2; ++db)
#pragma unroll
        for (int r = 0; r < 16; ++r) O[db][r] = 0.f;
    if (TYPE == 1) { mrun = P.sink[h] * LOG2E; lrun = (hi == 0) ? 1.f : 0.f; } else { mrun = -1e30f; lrun = 0.f; }
    const int qtok = qw + l31, qr = qtok >> 6, qc = qtok & 63, r0 = clampi(qr - 4, 0, 56), c0 = clampi(qc - 8, 0, 48);
    u32x4 kr0, kr1, vr; kr1 = (u32x4){0u, 0u, 0u, 0u};
    auto tile_row0 = [&](int i) { return (i < nloc) ? b * 4096 + (lo + i) * 64 : M_LAT + b * 256 + (i - nloc) * 64; };
#define ATT_PREFETCH(i) do { const int _r0 = tile_row0(i); \
        kr0 = *(const u32x4*)(K0p + (size_t)(_r0 + (tid >> 3)) * kpitch + (tid & 7) * 8); \
        if (TYPE == 2 && tid < 256) kr1 = *(const u32x4*)(K1p + (size_t)(_r0 + (tid >> 2)) * WA_N + (tid & 3) * 8); \
        vr = *(const u32x4*)(Vp + (size_t)(_r0 + (tid >> 3)) * kpitch + (tid & 7) * 8); } while (0)
#define ATT_WRITE(bufi) do { bf16_t* _Ks = (bf16_t*)(lds + (bufi) * BUFSZ); bf16_t* _Vt = (bf16_t*)(lds + (bufi) * BUFSZ + 64 * KPI * 2); \
        *(u32x4*)(_Ks + (tid >> 3) * KPI + (tid & 7) * 8) = kr0; \
        if (TYPE == 2 && tid < 256) *(u32x4*)(_Ks + (tid >> 2) * KPI + 64 + (tid & 3) * 8) = kr1; \
        bf16_t* vp = _Vt + ((tid & 7) * 8) * VPI + ((tid >> 3) ^ ((tid & 7) * 8));   \
        vp[0 * VPI] = (bf16_t)(vr.x & 0xffffu); vp[1 * VPI] = (bf16_t)(vr.x >> 16); vp[2 * VPI] = (bf16_t)(vr.y & 0xffffu); vp[3 * VPI] = (bf16_t)(vr.y >> 16); \
        vp[4 * VPI] = (bf16_t)(vr.z & 0xffffu); vp[5 * VPI] = (bf16_t)(vr.z >> 16); vp[6 * VPI] = (bf16_t)(vr.w & 0xffffu); vp[7 * VPI] = (bf16_t)(vr.w >> 16); } while (0)
    ATT_PREFETCH(0); ATT_WRITE(0); ATT_PREFETCH(1);
    __syncthreads();
    for (int i = 0; i < nt; ++i) {
        const bf16_t* Ks = (const bf16_t*)(lds + (i & 1) * BUFSZ); const bf16_t* Vt = (const bf16_t*)(lds + (i & 1) * BUFSZ + 64 * KPI * 2);
        const bool local = i < nloc; const int kt = lo + i;
        if (!(local && (kt < wlo || kt >= whi))) {
        f32x16 S[2];
#pragma unroll
        for (int kb = 0; kb < 2; ++kb) {
            bf16x8 Kf[NC];
#pragma unroll
            for (int c = 0; c < NC; ++c) Kf[c] = *(const bf16x8*)(Ks + (kb * 32 + l31) * KPI + c * 16 + hi * 8);
            __builtin_amdgcn_sched_barrier(0);
            f32x16 acc;
#pragma unroll
            for (int r = 0; r < 16; ++r) acc[r] = 0.f;
#pragma unroll
            for (int c = 0; c < NC; ++c) acc = __builtin_amdgcn_mfma_f32_32x32x16_bf16(Kf[c], Qf[c], acc, 0, 0, 0);
            S[kb] = acc;
            __builtin_amdgcn_sched_barrier(0);
        }
        u32x2 Vf[4][2];
#pragma unroll
        for (int ck = 0; ck < 4; ++ck) { const bf16_t* vp = Vt + l31 * VPI; const int sw = (l31 >> 3) * 8; Vf[ck][0] = *(const u32x2*)(vp + ((ck * 16 + hi * 4) ^ sw)); Vf[ck][1] = *(const u32x2*)(vp + ((ck * 16 + 8 + hi * 4) ^ sw)); }
        __builtin_amdgcn_sched_barrier(0);
        float mx = -1e30f;
#pragma unroll
        for (int kb = 0; kb < 2; ++kb)
#pragma unroll
            for (int r = 0; r < 16; ++r) {
                const int kk = kb * 32 + (r & 3) + 8 * (r >> 2) + 4 * hi;
                float t = S[kb][r];
                if (TYPE != 2 && local) {
                    if (TYPE == 0) { const bool ok = ((unsigned)(kt - r0) < 8u) && ((unsigned)(kk - c0) < 16u);
                        if (ok) t += rp[(kt - qr + 7) * 31 + (kk - qc + 15)]; else t = -1e30f; }
                    else if (TYPE == 1) { int dlt = qtok - (kt * 64 + kk); if (dlt < 0) dlt = -dlt; if (dlt > 128) t = -1e30f; }
                    S[kb][r] = t;
                }
                mx = fmaxf(mx, t);
            }
        mx = half_max(mx);
        float mn = mrun;
        if (__builtin_amdgcn_ballot_w64(mx > mrun + 8.f)) {
            mn = fmaxf(mrun, mx); const float alpha = __builtin_amdgcn_exp2f(mrun - mn); mrun = mn; lrun *= alpha;
#pragma unroll
            for (int db = 0; db < 2; ++db) O[db] *= alpha;
        }
        float ps = 0.f;
#pragma unroll
        for (int kb = 0; kb < 2; ++kb)
#pragma unroll
            for (int r = 0; r < 16; ++r) { const float t = S[kb][r];
                float pv = __builtin_amdgcn_exp2f(t - mn); if (TYPE != 2) pv = (t > -1e29f) ? pv : 0.f;
                S[kb][r] = pv; ps += pv; }
        lrun += ps;
        bf16x8 Pf[4];
#pragma unroll
        for (int kb = 0; kb < 2; ++kb)
#pragma unroll
            for (int m = 0; m < 2; ++m) { u32x4 w; w.x = cvt_pk_bf16(S[kb][8 * m], S[kb][8 * m + 1]); w.y = cvt_pk_bf16(S[kb][8 * m + 2], S[kb][8 * m + 3]);
                w.z = cvt_pk_bf16(S[kb][8 * m + 4], S[kb][8 * m + 5]); w.w = cvt_pk_bf16(S[kb][8 * m + 6], S[kb][8 * m + 7]); Pf[2 * kb + m] = __builtin_bit_cast(bf16x8, w); }
        u32x2 Vg[4][2];
#pragma unroll
        for (int ck = 0; ck < 4; ++ck) { const bf16_t* vp = Vt + (32 + l31) * VPI; const int sw = (4 + (l31 >> 3)) * 8; Vg[ck][0] = *(const u32x2*)(vp + ((ck * 16 + hi * 4) ^ sw)); Vg[ck][1] = *(const u32x2*)(vp + ((ck * 16 + 8 + hi * 4) ^ sw)); }
#pragma unroll
        for (int ck = 0; ck < 4; ++ck) { u32x4 w; w.x = Vf[ck][0].x; w.y = Vf[ck][0].y; w.z = Vf[ck][1].x; w.w = Vf[ck][1].y;
            O[0] = __builtin_amdgcn_mfma_f32_32x32x16_bf16(__builtin_bit_cast(bf16x8, w), Pf[ck], O[0], 0, 0, 0); }
#pragma unroll
        for (int ck = 0; ck < 4; ++ck) { u32x4 w; w.x = Vg[ck][0].x; w.y = Vg[ck][0].y; w.z = Vg[ck][1].x; w.w = Vg[ck][1].y;
            O[1] = __builtin_amdgcn_mfma_f32_32x32x16_bf16(__builtin_bit_cast(bf16x8, w), Pf[ck], O[1], 0, 0, 0); }
        }
        if (i + 1 < nt) ATT_WRITE((i + 1) & 1);
        __syncthreads();
        if (i + 2 < nt) ATT_PREFETCH(i + 2);
    }
#undef ATT_PREFETCH
#undef ATT_WRITE
    const int ycol = (TYPE == 0 ? 0 : (TYPE == 1 ? 512 : 1536)) + h * 64;
    const float inv = __builtin_amdgcn_rcpf(half_sum(lrun));
    bf16_t* yp = P.Y + (size_t)qrow * 2048 + ycol + hi * 4;
#pragma unroll
    for (int db = 0; db < 2; ++db)
#pragma unroll
        for (int rg = 0; rg < 4; ++rg) { u32x2 w; w.x = cvt_pk_bf16(O[db][4 * rg] * inv, O[db][4 * rg + 1] * inv); w.y = cvt_pk_bf16(O[db][4 * rg + 2] * inv, O[db][4 * rg + 3] * inv);
            *(u32x2*)(yp + db * 32 + rg * 8) = w; }
}
DEV void attn_phase(const int TID, unsigned char* lds, const AttnP& P, int nqt  ) {
    const int total = 3 * 512 + (nqt == 17 ? 96 : 0);
    const int vb = (gridDim.x % 8 == 0) ? (int)((blockIdx.x & 7) * (gridDim.x >> 3) + (blockIdx.x >> 3)) : (int)blockIdx.x;
    for (int it = vb; it < total; it += gridDim.x) {
        int type, b, h, qt;
        if (it < 1536) { type = 2 - (it >> 9); const int r = it & 511; qt = r & 15; h = (r >> 4) & 7; b = r >> 7; }
        else { const int r = it - 1536; type = 2 - r / 32; qt = 16; h = r & 7; b = (r >> 3) & 3; }
        if (type == 2) attn_item<2>(TID, lds, P, b, h, qt); else if (type == 1) attn_item<1>(TID, lds, P, b, h, qt); else attn_item<0>(TID, lds, P, b, h, qt);
    }
    __syncthreads();
}

DEV void mini_tile(const int TID, unsigned char* lds, const bf16_t* Ap, int lda, const bf16_t* Bp, int K, float (&v)[8], const int bstride = 16) {
    const int lane = TID & 63, wid = __builtin_amdgcn_readfirstlane(TID >> 6), fr = lane & 15, fq = lane >> 4;
    const int ksl = K >> 3, k0 = wid * ksl;
    f32x4 acc[4][4];
#pragma unroll
    for (int mb = 0; mb < 4; ++mb)
#pragma unroll
        for (int nb = 0; nb < 4; ++nb) acc[mb][nb] = (f32x4){0.f, 0.f, 0.f, 0.f};
    const bf16_t* ap = Ap + (size_t)fr * lda + k0 + fq * 8; const bf16_t* bp = Bp + (size_t)fr * K + k0 + fq * 8;
#pragma unroll 2
    for (int kk = 0; kk < ksl; kk += 32) {
        bf16x8 a[4], b[4];
#pragma unroll
        for (int i = 0; i < 4; ++i) { a[i] = *(const bf16x8*)(ap + (size_t)(i * 16) * lda + kk); b[i] = *(const bf16x8*)(bp + (size_t)(i * bstride) * K + kk); }
#pragma unroll
        for (int mb = 0; mb < 4; ++mb)
#pragma unroll
            for (int nb = 0; nb < 4; ++nb) acc[mb][nb] = __builtin_amdgcn_mfma_f32_16x16x32_bf16(a[mb], b[nb], acc[mb][nb], 0, 0, 0);
    }
    float* red = (float*)lds;
    __syncthreads();
#pragma unroll
    for (int mb = 0; mb < 4; ++mb)
#pragma unroll
        for (int nb = 0; nb < 4; ++nb)
#pragma unroll
            for (int j = 0; j < 4; ++j) red[wid * 4096 + (mb * 16 + fq * 4 + j) * 64 + nb * 16 + fr] = acc[mb][nb][j];
    __syncthreads();
    const float* rr = red + (TID >> 3) * 64 + (TID & 7) * 8;
    f32x4 s0 = *(const f32x4*)rr, s1 = *(const f32x4*)(rr + 4);
#pragma unroll
    for (int w = 1; w < 8; ++w) { s0 += *(const f32x4*)(rr + w * 4096); s1 += *(const f32x4*)(rr + w * 4096 + 4); }
    v[0] = s0[0]; v[1] = s0[1]; v[2] = s0[2]; v[3] = s0[3]; v[4] = s1[0]; v[5] = s1[1]; v[6] = s1[2]; v[7] = s1[3];
}
DEV void mini_resid(const int TID, unsigned char* lds, const bf16_t* A, int lda, const bf16_t* Bt, int K, const float* inc, float* outc, const float* gate, float s) {
    for (int it = blockIdx.x; it < 256; it += gridDim.x) {
        const int r0 = (it >> 4) * 64, c0 = (it & 15) * 64; float v[8];
        mini_tile(TID, lds, A + (size_t)(M_LAT + r0) * lda, lda, Bt + (size_t)c0 * K, K, v);
        const int row = r0 + (TID >> 3), col = c0 + (TID & 7) * 8; const size_t off = (size_t)row * D + col;
#pragma unroll
        for (int q = 0; q < 2; ++q) { const f32x4 g4 = *(const f32x4*)(gate + col + q * 4) * s, b4 = *(const f32x4*)(inc + off + q * 4);
            f32x4 a4; a4[0] = v[q * 4]; a4[1] = v[q * 4 + 1]; a4[2] = v[q * 4 + 2]; a4[3] = v[q * 4 + 3];
            *(f32x4*)(outc + off + q * 4) = b4 + g4 * a4; }
    }
    __syncthreads();
}
DEV void mini_pgemm(const int TID, unsigned char* lds, const bf16_t* Yb, const bf16_t* Wbr, bf16_t* PBo) {
    for (int it = blockIdx.x; it < 1024; it += gridDim.x) {
        const int r0 = (it >> 6) * 64, c0 = (it & 63) * 64; float v[8];
        mini_tile(TID, lds, Yb + (size_t)(M_LAT + r0) * 2048 + (c0 >> 10) * 512, 2048, Wbr + (size_t)c0 * 512, 512, v);
        const int row = M_LAT + r0 + (TID >> 3), col = c0 + (TID & 7) * 8;
        u32x4 w; w.x = cvt_pk_bf16(v[0], v[1]); w.y = cvt_pk_bf16(v[2], v[3]); w.z = cvt_pk_bf16(v[4], v[5]); w.w = cvt_pk_bf16(v[6], v[7]);
        *(u32x4*)(PBo + (size_t)row * 4096 + col) = w;
    }
    __syncthreads();
}
DEV void mini_merge(const int TID, unsigned char* lds, const bf16_t* XNb, const bf16_t* Wg, const bf16_t* PBi, bf16_t* MBo) {
    for (int it = blockIdx.x; it < 256; it += gridDim.x) {
        const int r0 = (it >> 4) * 64, c0 = (it & 15) * 64;
        const int row = M_LAT + r0 + (TID >> 3), col = c0 + (TID & 7) * 8;
        float R[8];
#pragma unroll
        for (int j = 0; j < 8; ++j) R[j] = 0.f;
#pragma unroll 1
        for (int n = 0; n < 4; ++n) {
            const int bro = (c0 >> 6) * 256 + (n >> 1) * 128 + (n & 1) * 16; float v[8];
            mini_tile(TID, lds, XNb + (size_t)(M_LAT + r0) * D, D, Wg + (size_t)bro * D, D, v, 32);
            const u32x4 pw = *(const u32x4*)(PBi + (size_t)row * 4096 + n * 1024 + col);
            R[0] += bflo(pw.x) * sigmoidf_(v[0]); R[1] += bfhi(pw.x) * sigmoidf_(v[1]); R[2] += bflo(pw.y) * sigmoidf_(v[2]); R[3] += bfhi(pw.y) * sigmoidf_(v[3]);
            R[4] += bflo(pw.z) * sigmoidf_(v[4]); R[5] += bfhi(pw.z) * sigmoidf_(v[5]); R[6] += bflo(pw.w) * sigmoidf_(v[6]); R[7] += bfhi(pw.w) * sigmoidf_(v[7]);
        }
        u32x4 w; w.x = cvt_pk_bf16(R[0], R[1]); w.y = cvt_pk_bf16(R[2], R[3]); w.z = cvt_pk_bf16(R[4], R[5]); w.w = cvt_pk_bf16(R[6], R[7]);
        *(u32x4*)(MBo + (size_t)row * D + col) = w;
    }
    __syncthreads();
}

#define LAS __attribute__((address_space(3)))
#define XB_TMO      128
#define XB_XCNT(j)  (256  + 64 * (j))
#define XB_XSUB(j)  (1280 + 64 * (j))
#define XB_XGEN(j)  (2304 + 64 * (j))
#define XB_TOP      3328
#define XB_TOPGEN   3392
#define XCD_BAR_WORDS 3456
#define XB_SPIN_CAP (1u << 18)

__device__ __forceinline__ unsigned xb_ld(unsigned* p)              { return __hip_atomic_load(p, __ATOMIC_RELAXED, __HIP_MEMORY_SCOPE_AGENT); }
__device__ __forceinline__ unsigned xb_add(unsigned* p, unsigned v) { return __hip_atomic_fetch_add(p, v, __ATOMIC_RELAXED, __HIP_MEMORY_SCOPE_AGENT); }
__device__ __forceinline__ unsigned xb_xcc_id() { return (unsigned)__builtin_amdgcn_s_getreg((3 << 11) | 20) & 0xFu; }
#define XB_SPIN(cond, bar) do { unsigned _sp = 0; while (cond) { __builtin_amdgcn_s_sleep(1); \
    if ((++_sp & 255u) == 0u) { if (xb_ld(&(bar)[XB_TMO])) break; if (_sp > XB_SPIN_CAP) { atomicAdd(&(bar)[XB_TMO], 1u); break; } } } } while (0)

struct XcdBarrier {
    unsigned* bar; unsigned x;
    volatile LAS unsigned* st;
};

__device__ __forceinline__ XcdBarrier xcd_barrier_post(unsigned* bar, volatile LAS unsigned* st) {
    XcdBarrier b; b.bar = bar; b.x = xb_xcc_id(); b.st = st;
    if (threadIdx.x == 0) (void)xb_add(&bar[XB_XCNT(b.x)], 1u);
    return b;
}
__device__ __forceinline__ void xcd_barrier_complete(unsigned* bar, unsigned x, unsigned& nloc, unsigned& nx) {
    const unsigned G = gridDim.x * gridDim.y * gridDim.z;
    unsigned sum, cnt, mine, sp = 0u;
    for (;;) {
        sum = 0u; cnt = 0u; mine = 0u;
#pragma unroll
        for (unsigned j = 0; j < 16; ++j) { const unsigned c = xb_ld(&bar[XB_XCNT(j)]); sum += c; cnt += (c > 0u) ? 1u : 0u; mine = (j == x) ? c : mine; }
        if (sum == G) break;
        __builtin_amdgcn_s_sleep(1);
        if ((++sp & 255u) == 0u) { if (xb_ld(&bar[XB_TMO])) break; if (sp > XB_SPIN_CAP) { atomicAdd(&bar[XB_TMO], 1u); break; } }
    }
    nloc = mine > 0u ? mine : 1u; nx = cnt > 0u ? cnt : 1u;
}

__device__ __forceinline__ void xcd_barrier(const XcdBarrier& b) {
    asm volatile("s_waitcnt vmcnt(0)" ::: "memory");
    __syncthreads();
    if (threadIdx.x == 0) {
        unsigned* bar = b.bar;
        __builtin_amdgcn_s_waitcnt(0);
        unsigned nloc = b.st[0], nx = b.st[1];
        if (nloc == 0u) { xcd_barrier_complete(bar, b.x, nloc, nx); b.st[0] = nloc; b.st[1] = nx; }
        const unsigned old = xb_add(&bar[XB_XSUB(b.x)], 1u);
        const unsigned gen = old / nloc;
        if (old + 1u == (gen + 1u) * nloc) {
            __builtin_amdgcn_fence(__ATOMIC_RELEASE, "agent");
            asm volatile("s_waitcnt vmcnt(0)" ::: "memory");
            const unsigned og = xb_add(&bar[XB_TOP], 1u);
            const unsigned tg = og / nx;
            if (og + 1u == (tg + 1u) * nx) xb_add(&bar[XB_TOPGEN], 1u);
            else XB_SPIN(xb_ld(&bar[XB_TOPGEN]) == tg, bar);
            __builtin_amdgcn_fence(__ATOMIC_ACQUIRE, "agent");
            xb_add(&bar[XB_XGEN(b.x)], 1u);
            asm volatile("s_waitcnt vmcnt(0)" ::: "memory");
        } else {
            XB_SPIN(xb_ld(&bar[XB_XGEN(b.x)]) == gen, bar);
            __builtin_amdgcn_fence(__ATOMIC_ACQUIRE, "agent");
            asm volatile("s_waitcnt vmcnt(0)" ::: "memory");
        }
    }
    __syncthreads();
}

#ifndef PHMASK
#define PHMASK 0xffffffffu
#endif
constexpr int PER_LAYER = 15;
constexpr int N_PHASES = 1 + 2 * PER_LAYER + 1;
__global__ void __launch_bounds__(NTHREADS, 2) fwd_kernel(KP pbyval) {
    extern __shared__ __attribute__((aligned(16))) unsigned char lds[];
    cg::grid_group grid = cg::this_grid();
    KPP p = (KPP)__builtin_amdgcn_kernarg_segment_ptr();
    const int ph_lo = p->ph_lo, ph_hi = p->ph_hi;
    const int wid_s = __builtin_amdgcn_readfirstlane((int)(threadIdx.x >> 6));
    volatile LAS unsigned* bst = (volatile LAS unsigned*)((LAS unsigned char*)lds + (LDS_BYTES - 64));
    if (threadIdx.x < 2) bst[threadIdx.x] = 0u;
    __syncthreads();
    const XcdBarrier xbar = xcd_barrier_post((unsigned*)(p->ws + WS_CTL), bst);
#pragma unroll 1
    for (int ph = ph_lo; ph < ph_hi; ++ph) {
        asm volatile("" : "+s"(p));
        unsigned allm = ~0u; asm volatile("" : "+s"(allm));
        int TID = (wid_s << 6) | (int)__builtin_amdgcn_mbcnt_hi(allm, __builtin_amdgcn_mbcnt_lo(allm, 0u)); asm volatile("" : "+v"(TID));
        int kind, l;
        if (ph < 1) { kind = 0; l = 0; } else if (ph == N_PHASES - 1) { kind = 18; l = 0; } else { l = (ph - 1) / PER_LAYER; kind = 2 + (ph - 1) % PER_LAYER; if (kind >= 9) kind += 1; }
        PG8_LAS unsigned char* ldsl = (PG8_LAS unsigned char*)lds;
        const int G = gridDim.x, cb = blockIdx.x;
        const bool last = (l == 1);
        const int Mpost = last ? M_LAT : M_ALL;
#define MOD ((float*)(p->ws + WS_MOD))
#define HC ((float*)(p->ws + WS_HC))
#define XN ((bf16_t*)(p->ws + WS_XN))
#define Y ((bf16_t*)(p->ws + WS_Y))
#define G5 ((bf16_t*)(p->ws + WS_G5))
#define WA ((bf16_t*)(p->ws + WS_BIG + BIG_WA))
#define MLAQ ((bf16_t*)(p->ws + WS_BIG + BIG_MLAQ))
#define MLAKV ((bf16_t*)(p->ws + WS_BIG + BIG_MLAKV))
#define ACT ((bf16_t*)(p->ws + WS_BIG))
#define PB ((bf16_t*)(p->ws + WS_BIG + BIG_P))
#define MB ((bf16_t*)(p->ws + WS_BIG + BIG_MB))
#define wb (p->ws + WS_WB)
#define modl (MOD + (size_t)l * 5 * 9 * 1024)
#define KIND(k) (((PHMASK >> (k)) & 1u) && kind == (k))
        if (KIND(0)) { modp_phase(TID, p, lds); wprep_phase(TID, p, lds, 0, 0); }
        else if (KIND(2)) { const float* hlat = (l == 0) ? p->in[0] : p->out; const float* hctx = (l == 0) ? p->in[2] : HC;
            norm_phase(TID, p, hlat, hctx, p->in[6] + l * D, modl, 0, M_ALL); if (l == 1) wprep_phase(TID, p, lds, 1, 0); }
        else if (KIND(3)) { pg8::Gemm g{XN, D, (const bf16_t*)(wb + WB_GU), M_ALL, 5632, D, 0, 0}; pg8::StaticOrder S; S.init(M_ALL, 5632, G, cb); EpiSwiglu E{ACT};
            pg8::gemm_phase<EpiSwiglu, pg8::StaticOrder, true, true>(TID, ldsl, g, S, E); }
        else if (KIND(4)) { const float* hlat = (l == 0) ? p->in[0] : p->out; const float* hctx = (l == 0) ? p->in[2] : HC;
            pg8::Gemm g{ACT, DFF, (const bf16_t*)(wb + WB_DN), M_LAT, D, DFF, 0, 0}; pg8::StaticOrder S; S.init(M_LAT, D, G, cb);
            EpiResid E{hlat, hctx, p->out, HC, modl + 2 * 1024, 0.5f};
            pg8::gemm_phase<EpiResid, pg8::StaticOrder, true, true>(TID, ldsl, g, S, E);
            mini_resid(TID, lds, ACT, DFF, (const bf16_t*)(wb + WB_DN), DFF, hctx, HC, modl + (size_t)(4 * 9 + 2) * 1024, 0.5f); }
        else if (KIND(5)) { norm_phase(TID, p, p->out, HC, p->in[10] + l * D, modl, 3, M_ALL); }
        else if (KIND(6)) { pg8::Gemm g{XN, D, (const bf16_t*)(wb + WB_INA), M_ALL, WA_N, D, 0, 0}; pg8::StaticOrder S; S.init(M_ALL, WA_N, G, cb); EpiStore E{WA, WA_N};
            pg8::gemm_phase<EpiStore, pg8::StaticOrder, true, true>(TID, ldsl, g, S, E);
            S5L L5{p->in[14] + l * 4096, p->in[15] + l * 4096, p->in[16] + l * 64, p->in[17] + (size_t)l * 65536, p->in[18] + (size_t)l * 65536,
                   p->in[19] + (size_t)l * 65536, p->in[20] + (size_t)l * 65536, p->in[21] + l * 512};
            const int nfull = (M_ALL / 256) * (WA_N / 256) - 3 * G;
            if (nfull > 0 && nfull < G) s5_pre_phase(TID, p, L5, lds, nfull, G - nfull); else s5_pre_phase(TID, p, L5, lds, 0, G); }
        else if (KIND(7) || KIND(8) || KIND(10)) {
            S5L L5{p->in[14] + l * 4096, p->in[15] + l * 4096, p->in[16] + l * 64, p->in[17] + (size_t)l * 65536, p->in[18] + (size_t)l * 65536,
                   p->in[19] + (size_t)l * 65536, p->in[20] + (size_t)l * 65536, p->in[21] + l * 512};
            if (kind == 7) { mlanorm_phase(TID, p, p->in[24] + l * 256, p->in[26] + l * 128); s5_local_phase(TID, p, L5); }
            else if (kind == 8) { s5_carry_phase(TID, p, L5);
                pg8::Gemm g{WA + C_CQ, WA_N, (const bf16_t*)(wb + WB_UQ), M_ALL, 768, 256, 0, 0}; pg8::StaticOrder S; S.init(M_ALL, 768, G, cb); EpiStore E{MLAQ, 768};
                pg8::gemm_phase<EpiStore, pg8::StaticOrder, true, true>(TID, ldsl, g, S, E);
                pg8::Gemm g2{WA + C_CKV, WA_N, (const bf16_t*)(wb + WB_UKV), M_ALL, 1024, 128, 0, 0}; pg8::StaticOrder S2; S2.init(M_ALL, 1024, G, cb); EpiStore E2{MLAKV, 1024};
                pg8::gemm_phase<EpiStore, pg8::StaticOrder, true, true>(TID, ldsl, g2, S2, E2); }
            else { AttnP AP{WA, MLAQ, MLAKV, Y, p->in[12] + l * 3720, p->in[13] + l * 8}; attn_phase(TID, lds, AP, last ? 16 : 17);
                s5_out_phase(TID, p, L5, last); }
        }
        else if (KIND(11)) { pg8::Gemm g{G5, 512, (const bf16_t*)(wb + WB_GLU), Mpost, 512, 512, 0, 0}; pg8::StaticOrder S; S.init(Mpost, 512, G, cb); EpiGlu E{G5, p->in[23] + l * 512, Y};
            pg8::gemm_phase<EpiGlu, pg8::StaticOrder, true, true>(TID, ldsl, g, S, E); wprep_phase(TID, p, lds, l, 1); }
        else if (KIND(12)) { pg8::Gemm g{Y, 2048, (const bf16_t*)(wb + WB_BR), M_LAT, 4096, 512, 4, 512}; pg8::StaticOrder S; S.init(M_LAT, 4096, G, cb); EpiStore E{PB, 4096};
            pg8::gemm_phase<EpiStore, pg8::StaticOrder, true, true>(TID, ldsl, g, S, E);
            if (!last) mini_pgemm(TID, lds, Y, (const bf16_t*)(wb + WB_BR), PB); }
        else if (KIND(13)) { pg8::Gemm g{XN, D, (const bf16_t*)(wb + WB_G), M_LAT, 4096, D, 0, 0}; pg8::StaticOrder S; S.init(M_LAT, 4096, G, cb); EpiMerge E{PB, MB};
            pg8::gemm_phase<EpiMerge, pg8::StaticOrder, true, true>(TID, ldsl, g, S, E);
            if (!last) mini_merge(TID, lds, XN, (const bf16_t*)(wb + WB_G), PB, MB); }
        else if (KIND(14)) { pg8::Gemm g{MB, D, (const bf16_t*)(wb + WB_OUT), M_LAT, D, D, 0, 0}; pg8::StaticOrder S; S.init(M_LAT, D, G, cb);
            EpiResid E{p->out, HC, p->out, HC, modl + 5 * 1024, 1.0f};
            pg8::gemm_phase<EpiResid, pg8::StaticOrder, true, true>(TID, ldsl, g, S, E);
            if (!last) mini_resid(TID, lds, MB, D, (const bf16_t*)(wb + WB_OUT), D, HC, HC, modl + (size_t)(4 * 9 + 5) * 1024, 1.0f); }
        else if (KIND(15)) { norm_phase(TID, p, p->out, HC, p->in[30] + l * D, modl, 6, Mpost); }
        else if (KIND(16)) { pg8::Gemm g{XN, D, (const bf16_t*)(wb + WB_GU), Mpost, 5632, D, 0, 0}; pg8::StaticOrder S; S.init(Mpost, 5632, G, cb); EpiSwiglu E{ACT};
            pg8::gemm_phase<EpiSwiglu, pg8::StaticOrder, true, true>(TID, ldsl, g, S, E); }
        else if (KIND(17)) { pg8::Gemm g{ACT, DFF, (const bf16_t*)(wb + WB_DN), M_LAT, D, DFF, 0, 0}; pg8::StaticOrder S; S.init(M_LAT, D, G, cb);
            EpiResid E{p->out, HC, p->out, HC, modl + 8 * 1024, 0.5f};
            pg8::gemm_phase<EpiResid, pg8::StaticOrder, true, true>(TID, ldsl, g, S, E);
            if (!last) mini_resid(TID, lds, ACT, DFF, (const bf16_t*)(wb + WB_DN), DFF, HC, HC, modl + (size_t)(4 * 9 + 8) * 1024, 0.5f); }
        else if (KIND(18)) { final_phase(TID, p); }
#undef KIND
#undef MOD
#undef HC
#undef XN
#undef Y
#undef G5
#undef WA
#undef MLAQ
#undef MLAKV
#undef ACT
#undef PB
#undef MB
#undef wb
#undef modl
        if (ph + 1 < ph_hi) { if (ph_lo < 0) grid.sync(); else xcd_barrier(xbar); }
    }
}

extern "C" void kernel_launch(void* const* d_in, const int* in_sizes, int n_in, void* d_out, int out_size, void* d_ws, size_t ws_size, hipStream_t stream) {
    static int grid = 0;
    if (grid == 0) {
        if (n_in != 35 || out_size != M_LAT * D || ws_size < WS_END) { fprintf(stderr, "kernel_launch: unexpected shapes (n_in %d out %d ws %zu need %zu)\n", n_in, out_size, ws_size, (size_t)WS_END); grid = -1; return; }
        int dev = 0, cus = 0, per_cu = 0;
        hipGetDevice(&dev); hipDeviceGetAttribute(&cus, hipDeviceAttributeMultiprocessorCount, dev);
        if (hipFuncSetAttribute((const void*)fwd_kernel, hipFuncAttributeMaxDynamicSharedMemorySize, LDS_BYTES) != hipSuccess) { fprintf(stderr, "kernel_launch: hipFuncSetAttribute failed\n"); grid = -1; return; }
        if (hipOccupancyMaxActiveBlocksPerMultiprocessor(&per_cu, (const void*)fwd_kernel, NTHREADS, LDS_BYTES) != hipSuccess || per_cu < 1) { fprintf(stderr, "kernel_launch: occupancy query failed (%d)\n", per_cu); (void)hipGetLastError(); per_cu = 1; }
        grid = cus * 1;
        if (grid < 8) grid = 8;
    }
    if (grid < 0) return;
    if (hipMemsetAsync((char*)d_ws, 0, WS_CTL + CTL_BYTES, stream) != hipSuccess) { fprintf(stderr, "kernel_launch: memset failed\n"); return; }
    KP a{};
    for (int i = 0; i < 35; ++i) a.in[i] = (const float*)d_in[i];
    a.out = (float*)d_out; a.ws = (unsigned char*)d_ws; a.ph_lo = 0; a.ph_hi = N_PHASES;
    void* args[] = {&a};
    hipError_t e = hipLaunchCooperativeKernel((const void*)fwd_kernel, dim3(grid), dim3(NTHREADS), args, LDS_BYTES, stream);
    if (e != hipSuccess) fprintf(stderr, "cooperative launch failed: %s (grid %d)\n", hipGetErrorString(e), grid);
}
```
